# Optimizing an MI355X kernel written in HIP

```python
import jax, jax.numpy as jnp
from jax import lax
import numpy as np

D_MODEL = 1024
BATCH = 8
SEQ = 4096
DEPTH = 2

G_GROUPS = 4
G_GROUP_DIM = 128
G_WIDTH = G_GROUPS * G_GROUP_DIM
G_CHUNK = 128
R_HEADS = 4
R_DK = 128
R_DV = 128
R_WIDTH = R_HEADS * R_DK
R_CHUNK = 64
A_HEADS = 8
A_HEAD_DIM = 64
A_WIDTH = A_HEADS * A_HEAD_DIM
A_BLOCK = 128
N_BRANCH = 3
D_FF = -(-8 * D_MODEL // (3 * 256)) * 256
LN_EPS = 1e-5
RMS_EPS = 1e-6
NEG_BIG = -1e30
LB_FLOOR = 1e-30
IN_SPLITS = (G_WIDTH, G_WIDTH, R_WIDTH, R_WIDTH, R_WIDTH, R_WIDTH,
             A_WIDTH, A_WIDTH, A_WIDTH, A_HEADS, N_BRANCH * D_MODEL)
IN_COLS = 2 * G_WIDTH + 4 * R_WIDTH + 3 * A_WIDTH + A_HEADS + N_BRANCH * D_MODEL

kernel_name = "hybrid_gmlp_hgrn2_fox_deepnorm"


def layer_norm(x, g, b):
    x32 = x.astype(jnp.float32)
    mu = jnp.mean(x32, axis=-1, keepdims=True)
    var = jnp.mean(jnp.square(x32 - mu), axis=-1, keepdims=True)
    y = (x32 - mu) * lax.rsqrt(var + LN_EPS)
    return (y * g.astype(jnp.float32) + b.astype(jnp.float32)).astype(x.dtype)


def gmlp_branch(u, v, ln_g, ln_b, w_s, b_s):
    B, S, _ = v.shape
    v = layer_norm(v, ln_g, ln_b)
    vc = v.reshape(B, S // G_CHUNK, G_CHUNK, G_GROUPS, G_GROUP_DIM)
    causal = jnp.tril(jnp.ones((G_CHUNK, G_CHUNK), dtype=bool))
    w = jnp.where(causal[None], w_s, 0)
    sv = jnp.einsum('gts,bnsgc->bntgc', w, vc) + b_s.T[None, None, :, :, None]
    return u * sv.reshape(B, S, G_WIDTH)


def to_chunks(t, heads, dim, chunk):
    B, S, _ = t.shape
    return t.reshape(B, S // chunk, chunk, heads, dim).transpose(1, 0, 3, 2, 4)


def hgrn2_branch(q, f_logit, i_in, g, lb, norm_w):
    B, S, _ = q.shape
    f32 = jnp.float32
    z = f_logit.astype(f32)
    lb = lb.astype(f32)
    log_lb = jnp.log(jnp.maximum(lb, LB_FLOOR))
    log_f = jnp.logaddexp(log_lb, jnp.log1p(-lb) + jax.nn.log_sigmoid(z))
    k = (1.0 - lb) * jax.nn.sigmoid(-z)
    qc = to_chunks(q.astype(f32), R_HEADS, R_DK, R_CHUNK)
    kc = to_chunks(k, R_HEADS, R_DK, R_CHUNK)
    vc = to_chunks(i_in.astype(f32), R_HEADS, R_DV, R_CHUNK)
    lfc = to_chunks(log_f, R_HEADS, R_DK, R_CHUNK)
    causal = jnp.tril(jnp.ones((R_CHUNK, R_CHUNK), dtype=bool))

    def step(state, inp):
        qb, kb, vb, lfb = inp
        cum = jnp.cumsum(lfb, axis=2)
        inter = jnp.einsum('bhtk,bhkv->bhtv', qb * jnp.exp(cum), state)
        diff = cum[:, :, :, None, :] - cum[:, :, None, :, :]
        decay = jnp.exp(jnp.where(causal[:, :, None], diff, NEG_BIG))
        scores = jnp.einsum('bhtk,bhtsk,bhsk->bhts', qb, decay, kb)
        intra = jnp.einsum('bhts,bhsv->bhtv', scores, vb)
        last = cum[:, :, -1:, :]
        new_state = (jnp.exp(last[:, :, 0, :])[..., None] * state
                     + jnp.einsum('bhsk,bhsv->bhkv', kb * jnp.exp(last - cum), vb))
        return new_state, inter + intra

    state0 = jnp.zeros((B, R_HEADS, R_DK, R_DV), f32)
    _, o = lax.scan(step, state0, (qc, kc, vc, lfc))
    o = o.transpose(1, 0, 3, 2, 4).reshape(B, S, R_HEADS, R_DV)
    gg = g.astype(f32).reshape(B, S, R_HEADS, R_DV)
    o = o * lax.rsqrt(jnp.mean(jnp.square(o), axis=-1, keepdims=True) + RMS_EPS)
    o = o * norm_w.astype(f32) * jax.nn.silu(gg)
    return o.reshape(B, S, R_WIDTH).astype(q.dtype)


def fox_branch(q, k, v, f_logit, f_bias):
    B, S, _ = q.shape
    nb = S // A_BLOCK
    scale = A_HEAD_DIM ** -0.5
    qh = q.reshape(B, S, A_HEADS, A_HEAD_DIM).transpose(0, 2, 1, 3)
    kh = k.reshape(B, S, A_HEADS, A_HEAD_DIM).transpose(0, 2, 1, 3)
    vh = v.reshape(B, S, A_HEADS, A_HEAD_DIM).transpose(0, 2, 1, 3)
    log_f = jax.nn.log_sigmoid(f_logit.astype(jnp.float32) + f_bias.astype(jnp.float32))
    F = jnp.cumsum(log_f, axis=1).transpose(0, 2, 1)
    q_blocks = qh.reshape(B, A_HEADS, nb, A_BLOCK, A_HEAD_DIM).transpose(2, 0, 1, 3, 4)
    F_blocks = F.reshape(B, A_HEADS, nb, A_BLOCK).transpose(2, 0, 1, 3)
    k_pos = jnp.arange(S)

    def block(args):
        qb, Fb, idx = args
        q_pos = idx * A_BLOCK + jnp.arange(A_BLOCK)
        s = (jnp.einsum('bhtd,bhsd->bhts', qb, kh).astype(jnp.float32) * scale
             + Fb[..., None] - F[:, :, None, :])
        s = jnp.where(k_pos[None, :] <= q_pos[:, None], s, NEG_BIG)
        p = jax.nn.softmax(s, axis=-1)
        return jnp.einsum('bhts,bhsd->bhtd', p.astype(vh.dtype), vh)

    out = lax.map(block, (q_blocks, F_blocks, jnp.arange(nb)))
    return out.transpose(1, 0, 3, 2, 4).reshape(B, S, A_WIDTH)


def mixer_block(x, w_in, g_ln_g, g_ln_b, g_ws, g_bs, r_lb, r_norm_w, a_fb,
                w_pg, w_pr, w_pa, w_o):
    B, S, _ = x.shape
    h = jnp.einsum('bsd,dc->bsc', x, w_in)
    offsets = [int(o) for o in np.cumsum(IN_SPLITS)[:-1]]
    (gu, gv, rq, rf, ri, rg, aq, ak, av, af, gate_logits) = jnp.split(h, offsets, axis=-1)
    y_g = gmlp_branch(jax.nn.gelu(gu, approximate=False), jax.nn.gelu(gv, approximate=False),
                      g_ln_g, g_ln_b, g_ws, g_bs)
    y_r = hgrn2_branch(rq, rf, ri, rg, r_lb, r_norm_w)
    y_a = fox_branch(aq, ak, av, af, a_fb)
    gates = jax.nn.sigmoid(gate_logits).reshape(B, S, N_BRANCH, D_MODEL)
    m = (gates[:, :, 0] * jnp.einsum('bsc,cd->bsd', y_g, w_pg)
         + gates[:, :, 1] * jnp.einsum('bsc,cd->bsd', y_r, w_pr)
         + gates[:, :, 2] * jnp.einsum('bsc,cd->bsd', y_a, w_pa))
    return jnp.einsum('bsd,de->bse', m, w_o)


def swiglu(x, w_gate, w_up, w_down):
    hid = jax.nn.silu(jnp.einsum('bsd,df->bsf', x, w_gate)) * jnp.einsum('bsd,df->bsf', x, w_up)
    return jnp.einsum('bsf,fd->bsd', hid, w_down)


def setup_inputs(seed: int = 0) -> dict:
    key = jax.random.key(seed)
    ks = jax.random.split(key, 24)
    beta = (8 * DEPTH) ** -0.25
    n = lambda k, shape: jax.random.normal(k, shape, jnp.float32)
    return {
        "x": n(ks[0], (BATCH, SEQ, D_MODEL)),
        "w_in": n(ks[1], (DEPTH, D_MODEL, IN_COLS)) * D_MODEL ** -0.5,
        "gmlp_ln_g": 1.0 + 0.01 * n(ks[2], (DEPTH, G_WIDTH)),
        "gmlp_ln_b": 0.01 * n(ks[3], (DEPTH, G_WIDTH)),
        "gmlp_ws": n(ks[4], (DEPTH, G_GROUPS, G_CHUNK, G_CHUNK)) * G_CHUNK ** -0.5,
        "gmlp_bs": 1.0 + 0.01 * n(ks[5], (DEPTH, G_GROUPS, G_CHUNK)),
        "hgrn_lb_logits": n(ks[6], (DEPTH, R_WIDTH)),
        "hgrn_norm_w": 1.0 + 0.01 * n(ks[7], (DEPTH, R_DV)),
        "fox_fb": 2.0 + 0.1 * n(ks[8], (DEPTH, A_HEADS)),
        "w_pg": n(ks[9], (DEPTH, G_WIDTH, D_MODEL)) * G_WIDTH ** -0.5 * beta,
        "w_pr": n(ks[10], (DEPTH, R_WIDTH, D_MODEL)) * R_WIDTH ** -0.5 * beta,
        "w_pa": n(ks[11], (DEPTH, A_WIDTH, D_MODEL)) * A_WIDTH ** -0.5 * beta,
        "w_o": n(ks[12], (DEPTH, D_MODEL, D_MODEL)) * D_MODEL ** -0.5 * beta,
        "ln1_g": 1.0 + 0.01 * n(ks[13], (DEPTH, D_MODEL)),
        "ln1_b": 0.01 * n(ks[14], (DEPTH, D_MODEL)),
        "w_gate": n(ks[15], (DEPTH, D_MODEL, D_FF)) * D_MODEL ** -0.5,
        "w_up": n(ks[16], (DEPTH, D_MODEL, D_FF)) * D_MODEL ** -0.5,
        "w_down": n(ks[17], (DEPTH, D_FF, D_MODEL)) * D_FF ** -0.5 * beta,
        "ln2_g": 1.0 + 0.01 * n(ks[18], (DEPTH, D_MODEL)),
        "ln2_b": 0.01 * n(ks[19], (DEPTH, D_MODEL)),
    }


def reference(x, w_in, gmlp_ln_g, gmlp_ln_b, gmlp_ws, gmlp_bs, hgrn_lb_logits, hgrn_norm_w,
              fox_fb, w_pg, w_pr, w_pa, w_o, ln1_g, ln1_b, w_gate, w_up, w_down, ln2_g, ln2_b):
    alpha = (2 * DEPTH) ** 0.25
    probs = jax.nn.softmax(hgrn_lb_logits.astype(jnp.float32), axis=0)
    lbs = jnp.cumsum(probs, axis=0) - probs[0:1]
    for l in range(DEPTH):
        y = mixer_block(x, w_in[l], gmlp_ln_g[l], gmlp_ln_b[l], gmlp_ws[l], gmlp_bs[l],
                        lbs[l], hgrn_norm_w[l], fox_fb[l], w_pg[l], w_pr[l], w_pa[l], w_o[l])
        x = layer_norm(alpha * x + y, ln1_g[l], ln1_b[l])
        x = layer_norm(alpha * x + swiglu(x, w_gate[l], w_up[l], w_down[l]), ln2_g[l], ln2_b[l])
    return x
```

```cpp
#include <hip/hip_cooperative_groups.h>
#include <hip/hip_runtime.h>
#include <cstdio>
#include <cstdint>
__device__ __forceinline__ int otid() { int t = threadIdx.x; asm volatile("" : "+v"(t)); return t; }
__device__ __forceinline__ int obid() { int b = blockIdx.x; asm volatile("" : "+s"(b)); return b; }
namespace pg8 {
#define PG8_LAS __attribute__((address_space(3)))
typedef unsigned short bf16_t;
typedef short bf16x8 __attribute__((ext_vector_type(8)));
typedef float f32x4 __attribute__((ext_vector_type(4)));
typedef unsigned u32x4 __attribute__((ext_vector_type(4)));
constexpr int BM = 256, BK = 64, HALF = 128, HTB = HALF * BK * 2  , STAGE_BYTES = 8 * HTB, NXCD = 8, WGM = 8;

__host__ __device__ __forceinline__ int lds_byte(int r, int c) { const int st = (r >> 4) * 2 + (c >> 5), rr = r & 15, cc = c & 31, ob = rr * 64 + cc * 2; return st * 1024 + (ob ^ (((ob >> 9) & 1) << 5)); }
__host__ __device__ __forceinline__ void stage_rc(int b, int& R, int& C) { const int st = b / 1024, sb = b % 1024, swz = sb ^ (((sb >> 9) & 1) << 5); R = (st >> 1) * 16 + swz / 64; C = (st & 1) * 32 + (swz % 64) / 2; }
__host__ __device__ __forceinline__ int perm32(int rho) { const int n = rho >> 4, i = rho & 15; return 8 * (i >> 2) + 4 * n + (i & 3); }

struct Unit { int pm, pn; };
struct Gemm { const bf16_t* A; const bf16_t* Bt; int M, N, K; };

struct StaticOrder {
    int nM, nN, nwg, G, c;
    __host__ __device__ void init(int M, int N, int G_, int c_) { nM = M / BM; nN = N / BM; nwg = nM * nN; G = G_; c = c_; }
    __host__ __device__ bool next(int i, Unit& u) const {
        const long L = (long)i * G + c; if (L >= nwg) return false;
        int wgid = (int)L; { const int q = nwg / NXCD, r = nwg % NXCD, xcd = wgid % NXCD, off = wgid / NXCD; wgid = (xcd < r ? xcd * (q + 1) : r * (q + 1) + (xcd - r) * q) + off; }
        const int nig = WGM * nN, gid = wgid / nig, fm = gid * WGM, gsz = (nM - fm) < WGM ? (nM - fm) : WGM;
        u.pm = fm + ((wgid % nig) % gsz); u.pn = (wgid % nig) / gsz; return true;
    }
    __device__ __forceinline__ void a_ready(const Unit&) const {}
    __device__ __forceinline__ void done(const Unit&) const {}
};

typedef float f32x2c_t __attribute__((ext_vector_type(2))); typedef __bf16 bf16x2c_t __attribute__((ext_vector_type(2)));
__device__ __forceinline__ unsigned cvt_pk_bf16(float lo, float hi) { f32x2c_t v = {lo, hi}; bf16x2c_t b = __builtin_convertvector(v, bf16x2c_t); return __builtin_bit_cast(unsigned, b); }
typedef float f32x2 __attribute__((ext_vector_type(2)));
__device__ __forceinline__ f32x2 gelu_pk(f32x2 v) {
    const f32x2 av = __builtin_elementwise_abs(v), d = av * 0.2316418882f + 1.0f;
    f32x2 t; t.x = __builtin_amdgcn_rcpf(d.x); t.y = __builtin_amdgcn_rcpf(d.y);
    f32x2 q = t * 0.5307027145f + (-0.7265760135f); q = q * t + 0.7107068705f; q = q * t + (-0.142248368f); q = q * t + 0.127414796f; q = q * t;
    const f32x2 s = (v * v) * (-0.72134752044f);
    f32x2 e; e.x = __builtin_amdgcn_exp2f(s.x); e.y = __builtin_amdgcn_exp2f(s.y);
    const f32x2 m = v * (q * e), r = v - m;
    f32x2 o; o.x = v.x < 0.f ? m.x : r.x; o.y = v.y < 0.f ? m.y : r.y; return o;
}

constexpr int HPITCH = 7936;
constexpr float QSCALE = 0.125f * 1.4426950408889634f;
__device__ __forceinline__ float bflo(unsigned w) { return __uint_as_float(w << 16); }
__device__ __forceinline__ float bfhi(unsigned w) { return __uint_as_float(w & 0xffff0000u); }
__device__ __forceinline__ float sigm(float x) { return 1.0f / (1.0f + __expf(-x)); }
struct EpiH {
    static constexpr bool PERM = true, AFTER_DRAIN = false;
    bf16_t* O;
    __device__ __forceinline__ void operator()(const f32x4 (&acc)[2][2][4][2], const Unit& u, int wr, int wc, int fr, int fq) const {
        const int row0 = u.pm * BM + wr * 64 + fr; const int col0 = u.pn * BM + wc * 32 + 8 * fq;
        const bool dogelu = u.pn < 4; const float sc = (u.pn == 12 || u.pn == 13) ? QSCALE : 1.f;
#pragma unroll
        for (int ai = 0; ai < 2; ++ai)
#pragma unroll
            for (int m = 0; m < 4; ++m) { bf16_t* rowp = O + (size_t)(row0 + ai * HALF + m * 16) * HPITCH + col0;
#pragma unroll
                for (int bj = 0; bj < 2; ++bj) { f32x4 v0 = acc[ai][bj][m][0], v1 = acc[ai][bj][m][1];
                    if (dogelu) { f32x2 a = gelu_pk((f32x2){v0[0], v0[1]}), b = gelu_pk((f32x2){v0[2], v0[3]}), c = gelu_pk((f32x2){v1[0], v1[1]}), d = gelu_pk((f32x2){v1[2], v1[3]});
                        v0 = (f32x4){a.x, a.y, b.x, b.y}; v1 = (f32x4){c.x, c.y, d.x, d.y}; }
                    v0 = v0 * sc; v1 = v1 * sc; u32x4 w; w.x = cvt_pk_bf16(v0[0], v0[1]); w.y = cvt_pk_bf16(v0[2], v0[3]); w.z = cvt_pk_bf16(v1[0], v1[1]); w.w = cvt_pk_bf16(v1[2], v1[3]);
                    *(u32x4*)(rowp + bj * HALF) = w; } }
    }
};
struct EpiProj {
    static constexpr bool PERM = true, AFTER_DRAIN = false;
    const bf16_t* Hh; bf16_t* MB;
    __device__ __forceinline__ void operator()(const f32x4 (&acc)[2][2][4][2], const Unit& u, int wr, int wc, int fr, int fq) const {
        const int br = u.pn >> 2, pnn = u.pn & 3, pmm = u.pm & 63;
        const int row0 = pmm * BM + wr * 64 + fr; const int col0 = pnn * BM + wc * 32 + 8 * fq;
#pragma unroll
        for (int ai = 0; ai < 2; ++ai)
#pragma unroll
            for (int m = 0; m < 4; ++m) { const size_t row = (size_t)(row0 + ai * HALF + m * 16);
#pragma unroll
                for (int bj = 0; bj < 2; ++bj) { const int col = col0 + bj * HALF;
                    const u32x4 gw = *(const u32x4*)(Hh + row * HPITCH + 4608 + br * 1024 + col);
                    const f32x4 v0 = acc[ai][bj][m][0], v1 = acc[ai][bj][m][1];
                    float r0 = sigm(bflo(gw.x)) * v0[0], r1 = sigm(bfhi(gw.x)) * v0[1], r2 = sigm(bflo(gw.y)) * v0[2], r3 = sigm(bfhi(gw.y)) * v0[3];
                    float r4 = sigm(bflo(gw.z)) * v1[0], r5 = sigm(bfhi(gw.z)) * v1[1], r6 = sigm(bflo(gw.w)) * v1[2], r7 = sigm(bfhi(gw.w)) * v1[3];
                    bf16_t* mp = MB + row * 1024 + col;
                    if (br > 0) { const u32x4 o = *(const u32x4*)mp; r0 += bflo(o.x); r1 += bfhi(o.x); r2 += bflo(o.y); r3 += bfhi(o.y); r4 += bflo(o.z); r5 += bfhi(o.z); r6 += bflo(o.w); r7 += bfhi(o.w); }
                    u32x4 w; w.x = cvt_pk_bf16(r0, r1); w.y = cvt_pk_bf16(r2, r3); w.z = cvt_pk_bf16(r4, r5); w.w = cvt_pk_bf16(r6, r7);
                    *(u32x4*)mp = w; } }
    }
};
struct EpiResid {
    static constexpr bool PERM = false, AFTER_DRAIN = false;
    const float* base; float* out; float alpha;
    __device__ __forceinline__ void operator()(const f32x4 (&acc)[2][2][4][2], const Unit& u, int wr, int wc, int fr, int fq) const {
        const int row0 = u.pm * BM + wr * 64 + fr; const int col0 = u.pn * BM + wc * 32 + 4 * fq;
#pragma unroll
        for (int ai = 0; ai < 2; ++ai)
#pragma unroll
            for (int m = 0; m < 4; ++m) { const size_t off = (size_t)(row0 + ai * HALF + m * 16) * 1024 + col0;
#pragma unroll
                for (int bj = 0; bj < 2; ++bj)
#pragma unroll
                    for (int n = 0; n < 2; ++n) { const f32x4 b = *(const f32x4*)(base + off + bj * HALF + n * 16); *(f32x4*)(out + off + bj * HALF + n * 16) = b * alpha + acc[ai][bj][m][n]; } }
    }
};
struct EpiSwiglu {
    static constexpr bool PERM = true, AFTER_DRAIN = false;
    bf16_t* O;
    __device__ __forceinline__ void operator()(const f32x4 (&acc)[2][2][4][2], const Unit& u, int wr, int wc, int fr, int fq) const {
        const int row0 = u.pm * BM + wr * 64 + fr; const int col0 = u.pn * HALF + wc * 32 + 8 * fq;
#pragma unroll
        for (int ai = 0; ai < 2; ++ai)
#pragma unroll
            for (int m = 0; m < 4; ++m) { const f32x4 g0 = acc[ai][0][m][0], g1 = acc[ai][0][m][1], u0 = acc[ai][1][m][0], u1 = acc[ai][1][m][1];
                u32x4 w; w.x = cvt_pk_bf16(g0[0] * sigm(g0[0]) * u0[0], g0[1] * sigm(g0[1]) * u0[1]); w.y = cvt_pk_bf16(g0[2] * sigm(g0[2]) * u0[2], g0[3] * sigm(g0[3]) * u0[3]);
                w.z = cvt_pk_bf16(g1[0] * sigm(g1[0]) * u1[0], g1[1] * sigm(g1[1]) * u1[1]); w.w = cvt_pk_bf16(g1[2] * sigm(g1[2]) * u1[2], g1[3] * sigm(g1[3]) * u1[3]);
                *(u32x4*)(O + (size_t)(row0 + ai * HALF + m * 16) * 2816 + col0) = w; }
    }
};
struct ProjOrder {
    int G, c;
    __device__ __forceinline__ bool next(int i, Unit& u) const { const int tile = c + (i / 3) * G; if (tile >= 256) return false; const int br = i % 3; u.pm = br * 64 + (tile >> 2); u.pn = br * 4 + (tile & 3); return true; }
    __device__ __forceinline__ void a_ready(const Unit&) const {}
    __device__ __forceinline__ void done(const Unit&) const {}
};
template <class Epi, class Sched, bool ALIGN_EPI = false, bool SP2 = false>
__device__ __forceinline__ void gemm_phase(PG8_LAS unsigned char* lds, const Gemm g, const Sched& S, const Epi& E) {
    const int tid = otid(), wid = __builtin_amdgcn_readfirstlane(tid >> 6), lane = tid & 63, wr = wid >> 2, wc = wid & 3, fr = lane & 15, fq = lane >> 4;
    const int K = g.K, nt = K / BK;
    unsigned voffA[2], voffB[2];
#pragma unroll
    for (int i = 0; i < 2; ++i) { int R, C; stage_rc(tid * 16 + i * 8192, R, C); const int Rb = Epi::PERM ? ((R & ~31) + perm32(R & 31)) : R;
        voffA[i] = (unsigned)(R * K + C) * 2u; voffB[i] = (unsigned)(Rb * K + C) * 2u; }
    const size_t kstep = (size_t)(BK * 2);
    const size_t hstep = (size_t)HALF * K * 2;
    const size_t tstep = 2 * hstep;
    const unsigned ldsw = (unsigned)wid * 1024u;
    const int aoff = lds_byte(wr * 64 + fr, fq * 8), boff = lds_byte(wc * 32 + fr, fq * 8);
#define PG8_SA(b, h) (((b) * 2 + (h)) * HTB)
#define PG8_SB(b, h) ((4 + (b) * 2 + (h)) * HTB)
#define PG8_STAGE(bufoff, gbase, voff) do { _Pragma("unroll") for (int _i = 0; _i < 2; ++_i) \
        __builtin_amdgcn_global_load_lds((const unsigned*)((const char*)(gbase) + (voff)[_i]), (PG8_LAS unsigned*)(lds + (bufoff) + ldsw + _i * 8192), 16, 0, 0); } while (0)
#define PG8_LDA(dst, b, h) do { _Pragma("unroll") for (int m = 0; m < 4; ++m) _Pragma("unroll") for (int k = 0; k < 2; ++k) dst[m][k] = *(const PG8_LAS bf16x8*)(lds + PG8_SA(b, h) + aoff + m * 2048 + k * 1024); } while (0)
#define PG8_LDB(dst, b, h) do { _Pragma("unroll") for (int n = 0; n < 2; ++n) _Pragma("unroll") for (int k = 0; k < 2; ++k) dst[n][k] = *(const PG8_LAS bf16x8*)(lds + PG8_SB(b, h) + boff + n * 2048 + k * 1024); } while (0)
#define PG8_MMA(ai, bj, At, Bt) do { __builtin_amdgcn_s_setprio(1); _Pragma("unroll") for (int m = 0; m < 4; ++m) _Pragma("unroll") for (int n = 0; n < 2; ++n) _Pragma("unroll") for (int k = 0; k < 2; ++k) \
        acc[ai][bj][m][n] = __builtin_amdgcn_mfma_f32_16x16x32_bf16(Bt[n][k], At[m][k], acc[ai][bj][m][n], 0, 0, 0); __builtin_amdgcn_s_setprio(0); } while (0)
#define PG8_WAIT_V(n) asm volatile("s_waitcnt vmcnt(" #n ")" ::: "memory")
#define PG8_WAIT_L(n) asm volatile("s_waitcnt lgkmcnt(" #n ")" ::: "memory")
#define PG8_BAR __builtin_amdgcn_s_barrier()
#define PG8_SCHED __builtin_amdgcn_sched_barrier(0)
    Unit cur, nxt; int ui = 0;
    if (!S.next(0, cur)) return;
    f32x4 acc[2][2][4][2];
#pragma unroll
    for (int a = 0; a < 2; ++a)
#pragma unroll
        for (int b = 0; b < 2; ++b)
#pragma unroll
            for (int m = 0; m < 4; ++m)
#pragma unroll
                for (int n = 0; n < 2; ++n) acc[a][b][m][n] = (f32x4){0.f, 0.f, 0.f, 0.f};
    bf16x8 At[4][2], B0[2][2], B1[2][2];
    const char* cA = (const char*)g.A + (size_t)cur.pm * tstep; const char* cB = (const char*)g.Bt + (size_t)cur.pn * tstep;
    S.a_ready(cur);
    if constexpr (SP2) {
        PG8_STAGE(PG8_SB(0, 0), cB, voffB); PG8_STAGE(PG8_SB(0, 1), cB + hstep, voffB); PG8_STAGE(PG8_SA(0, 0), cA, voffA); PG8_STAGE(PG8_SA(0, 1), cA + hstep, voffA);
        if (wr == 1) PG8_BAR;
        PG8_WAIT_V(2); PG8_BAR;
        PG8_STAGE(PG8_SB(1, 0), cB + kstep, voffB); PG8_STAGE(PG8_SA(1, 0), cA + kstep, voffA); PG8_STAGE(PG8_SB(1, 1), cB + hstep + kstep, voffB);
        PG8_WAIT_V(6); PG8_BAR;
    } else {
        PG8_STAGE(PG8_SB(0, 0), cB, voffB); PG8_STAGE(PG8_SA(0, 0), cA, voffA); PG8_STAGE(PG8_SB(0, 1), cB + hstep, voffB); PG8_STAGE(PG8_SA(0, 1), cA + hstep, voffA);
        if (wr == 1) PG8_BAR;
        PG8_WAIT_V(4); PG8_BAR;
        PG8_STAGE(PG8_SB(1, 0), cB + kstep, voffB); PG8_STAGE(PG8_SA(1, 0), cA + kstep, voffA); PG8_STAGE(PG8_SB(1, 1), cB + hstep + kstep, voffB);
        PG8_WAIT_V(6); PG8_BAR;
    }
    for (;;) {
        const bool has_next = S.next(ui + 1, nxt);
        const char* nA = has_next ? (const char*)g.A + (size_t)nxt.pm * tstep : cA; const char* nB = has_next ? (const char*)g.Bt + (size_t)nxt.pn * tstep : cB;
        for (int t = 0; t < nt; t += 2) {
            const bool last = (t == nt - 2);
            const char* a1 = cA + (size_t)(t + 1) * kstep;
            const char* a2 = last ? nA : cA + (size_t)(t + 2) * kstep; const char* b2 = last ? nB : cB + (size_t)(t + 2) * kstep;
            const char* a3 = a2 + kstep; const char* b3 = b2 + kstep;
            if (last && has_next) S.a_ready(nxt);
            if constexpr (SP2) {
            PG8_LDB(B0, 0, 0); PG8_LDB(B1, 0, 1); PG8_SCHED; PG8_LDA(At, 0, 0); PG8_STAGE(PG8_SA(1, 1), a1 + hstep, voffA);
            PG8_WAIT_V(8); PG8_WAIT_L(0); PG8_BAR; PG8_MMA(0, 0, At, B0); PG8_MMA(0, 1, At, B1); PG8_BAR; PG8_SCHED;
            PG8_LDA(At, 0, 1); PG8_STAGE(PG8_SB(0, 0), b2, voffB); PG8_STAGE(PG8_SB(0, 1), b2 + hstep, voffB); PG8_STAGE(PG8_SA(0, 0), a2, voffA);
            PG8_WAIT_V(8); PG8_WAIT_L(0); PG8_BAR; PG8_MMA(1, 0, At, B0); PG8_MMA(1, 1, At, B1); PG8_BAR; PG8_SCHED;
            PG8_LDB(B0, 1, 0); PG8_LDB(B1, 1, 1); PG8_SCHED; PG8_LDA(At, 1, 0); PG8_STAGE(PG8_SA(0, 1), a2 + hstep, voffA);
            PG8_WAIT_V(8); PG8_WAIT_L(0); PG8_BAR; PG8_MMA(0, 0, At, B0); PG8_MMA(0, 1, At, B1); PG8_BAR; PG8_SCHED;
            PG8_LDA(At, 1, 1); PG8_STAGE(PG8_SB(1, 0), b3, voffB); PG8_STAGE(PG8_SB(1, 1), b3 + hstep, voffB); PG8_STAGE(PG8_SA(1, 0), a3, voffA);
            PG8_WAIT_V(8); PG8_WAIT_L(0); PG8_BAR; PG8_MMA(1, 0, At, B0); PG8_MMA(1, 1, At, B1); PG8_BAR; PG8_SCHED;
            } else {
            PG8_LDB(B0, 0, 0); PG8_SCHED; PG8_LDA(At, 0, 0); PG8_STAGE(PG8_SA(1, 1), a1 + hstep, voffA);
            PG8_WAIT_L(8); PG8_BAR; PG8_WAIT_L(0); PG8_MMA(0, 0, At, B0); PG8_BAR; PG8_SCHED;
            PG8_LDB(B1, 0, 1); PG8_STAGE(PG8_SB(0, 0), b2, voffB);
            PG8_BAR; PG8_WAIT_L(0); PG8_MMA(0, 1, At, B1); PG8_BAR;
            PG8_LDA(At, 0, 1); PG8_STAGE(PG8_SA(0, 0), a2, voffA);
            PG8_BAR; PG8_WAIT_L(0); PG8_MMA(1, 0, At, B0); PG8_BAR; PG8_SCHED;
            PG8_STAGE(PG8_SB(0, 1), b2 + hstep, voffB);
            PG8_WAIT_V(6); PG8_BAR; PG8_MMA(1, 1, At, B1); PG8_BAR;
            PG8_LDB(B0, 1, 0); PG8_SCHED; PG8_LDA(At, 1, 0); PG8_STAGE(PG8_SA(0, 1), a2 + hstep, voffA);
            PG8_WAIT_L(8); PG8_BAR; PG8_WAIT_L(0); PG8_MMA(0, 0, At, B0); PG8_BAR; PG8_SCHED;
            PG8_LDB(B1, 1, 1); PG8_STAGE(PG8_SB(1, 0), b3, voffB);
            PG8_BAR; PG8_WAIT_L(0); PG8_MMA(0, 1, At, B1); PG8_BAR;
            PG8_LDA(At, 1, 1); PG8_STAGE(PG8_SA(1, 0), a3, voffA);
            PG8_BAR; PG8_WAIT_L(0); PG8_MMA(1, 0, At, B0); PG8_BAR; PG8_SCHED;
            PG8_STAGE(PG8_SB(1, 1), b3 + hstep, voffB);
            PG8_WAIT_V(6); PG8_BAR; PG8_MMA(1, 1, At, B1); PG8_BAR;
            }
        }
        if constexpr (ALIGN_EPI) { if (wr == 0) PG8_BAR; }
        if constexpr (!Epi::AFTER_DRAIN) { E(acc, cur, wr, wc, fr, fq); S.done(cur); }
        if (!has_next) break;
#pragma unroll
        for (int a = 0; a < 2; ++a)
#pragma unroll
            for (int b = 0; b < 2; ++b)
#pragma unroll
                for (int m = 0; m < 4; ++m)
#pragma unroll
                    for (int n = 0; n < 2; ++n) acc[a][b][m][n] = (f32x4){0.f, 0.f, 0.f, 0.f};
        cur = nxt; cA = nA; cB = nB; ++ui;
        if constexpr (ALIGN_EPI) { if (wr == 1) PG8_BAR; }
    }
    PG8_WAIT_V(0);
    if constexpr (!ALIGN_EPI) { if (wr == 0) PG8_BAR; }
    PG8_BAR;
    if constexpr (Epi::AFTER_DRAIN) { E.fused(acc, cur, wr, wc, fr, fq, lds, wid, lane); S.done(cur); }
#undef PG8_SA
#undef PG8_SB
#undef PG8_STAGE
#undef PG8_LDA
#undef PG8_LDB
#undef PG8_MMA
#undef PG8_WAIT_V
#undef PG8_WAIT_L
#undef PG8_BAR
#undef PG8_SCHED
}
}

#ifndef PG8_SP2
#define PG8_SP2 true
#endif
#ifndef PG8_ALIGN
#define PG8_ALIGN true
#endif
namespace cg = cooperative_groups;
#define LAS __attribute__((address_space(3)))
typedef unsigned short bf16;
typedef short bf16x8 __attribute__((ext_vector_type(8)));
typedef float f32x4 __attribute__((ext_vector_type(4)));
typedef float f32x16 __attribute__((ext_vector_type(16)));
typedef unsigned u32x4 __attribute__((ext_vector_type(4)));
typedef unsigned u32x2 __attribute__((ext_vector_type(2)));
using pg8::bflo; using pg8::bfhi; using pg8::sigm; using pg8::cvt_pk_bf16;

constexpr int T_ALL = 32768, TH = 16384, DM = 1024, SEQ = 4096, HP = pg8::HPITCH, DFF = 2816, INC = 7688;
constexpr int C_GU = 0, C_GV = 512, C_RQ = 1024, C_RF = 1536, C_RI = 2048, C_RG = 2560, C_AQ = 3072, C_AK = 3584, C_AV = 4096, C_GATE = 4608, C_AF = 7680;
constexpr float LOG2E = 1.4426950408889634f;
constexpr size_t MiB = 1u << 20;
constexpr size_t WS_CTL = 0, WS_W = 1 * MiB, W_LAYER = 37 * MiB;
constexpr size_t WIN_OFF = 0, WP_OFF = 16252928, WO_OFF = WP_OFF + 3145728, WGU_OFF = WO_OFF + 2097152, WD_OFF = WGU_OFF + 11534336;
static_assert(WD_OFF + 5767168 == W_LAYER, "weight map");
constexpr size_t WS_XB = 75 * MiB, WS_H = 139 * MiB, WS_Y = 387 * MiB, WS_MB = 435 * MiB, WS_U = 467 * MiB, WS_DEC = 499 * MiB, WS_GF = WS_DEC + 512 * 1024, WS_END = 500 * MiB;
constexpr int LDS_BYTES = 147456;
constexpr int NPHASE = 33;

struct Args {
    const float *x, *w_in, *gln_g, *gln_b, *g_ws, *g_bs, *lb_logits, *r_norm_w, *fox_fb, *w_pg, *w_pr, *w_pa, *w_o, *ln1_g, *ln1_b, *w_gate, *w_up, *w_down, *ln2_g, *ln2_b;
    float* out; unsigned char* ws; int lo, hi;
};

__device__ __forceinline__ unsigned short f2bf(float f) { unsigned u = __float_as_uint(f); return (unsigned short)((u + 0x7fffu + ((u >> 16) & 1u)) >> 16); }
__device__ __forceinline__ float bf2f(unsigned short b) { return __uint_as_float((unsigned)b << 16); }
__device__ __forceinline__ float wave_sum(float v) {
#pragma unroll
    for (int o = 1; o < 64; o <<= 1) v += __shfl_xor(v, o);
    return v;
}
__device__ __forceinline__ f32x4 mfma16(bf16x8 a, bf16x8 b, f32x4 c) { return __builtin_amdgcn_mfma_f32_16x16x32_bf16(a, b, c, 0, 0, 0); }
__device__ __forceinline__ f32x16 mfma32(bf16x8 a, bf16x8 b, f32x16 c) { return __builtin_amdgcn_mfma_f32_32x32x16_bf16(a, b, c, 0, 0, 0); }

__device__ __forceinline__ int rowmap(int mode, int n) {
    if (mode == 1) return n < 4608 ? n : (n < 4616 ? 7680 + (n - 4608) : 4608 + (n - 4616));
    if (mode == 2) return (n >> 7) * 256 + (n & 127);
    if (mode == 3) return (n >> 7) * 256 + 128 + (n & 127);
    return n;
}
__device__ __forceinline__ void transpose_item(const float* W, int K, int N, bf16* WT, int mode, int row_off, LAS float* scr, int item, int lane) {
    const int nblk = (N + 31) / 32, kb = item / nblk, nb = item % nblk, k0 = 64 * kb, n0 = 32 * nb;
    const int nn = n0 + (lane & 31);
#pragma unroll 8
    for (int i = 0; i < 32; ++i) { const int kk = 2 * i + (lane >> 5); scr[kk * 33 + (lane & 31)] = nn < N ? W[(size_t)(k0 + kk) * N + nn] : 0.f; }
    asm volatile("s_waitcnt lgkmcnt(0)" ::: "memory");
    const int c = lane & 7;
#pragma unroll
    for (int j = 0; j < 4; ++j) { const int n = (lane >> 3) + 8 * j; const LAS float* s = scr + (8 * c) * 33 + n;
        u32x4 o; o.x = cvt_pk_bf16(s[0 * 33], s[1 * 33]); o.y = cvt_pk_bf16(s[2 * 33], s[3 * 33]); o.z = cvt_pk_bf16(s[4 * 33], s[5 * 33]); o.w = cvt_pk_bf16(s[6 * 33], s[7 * 33]);
        if (n0 + n < N) *(u32x4*)(WT + (size_t)(row_off + rowmap(mode, n0 + n)) * K + k0 + 8 * c) = o; }
    asm volatile("s_waitcnt lgkmcnt(0)" ::: "memory");
}
__device__ __forceinline__ void prep_phase(const Args& a, LAS unsigned char* lds) {
    const int tid = otid(), lane = tid & 63, wave = tid >> 6;
    const int gw = obid() * 8 + wave, NGW = gridDim.x * 8;
    LAS float* scr = (LAS float*)(lds + wave * 16384);
    constexpr int I_IN = 16 * 241, I_P = 8 * 32, I_O = 16 * 32, I_G = 16 * 88, I_D = 44 * 32;
    constexpr int PER_L = I_IN + 3 * I_P + I_O + 2 * I_G + I_D;
    for (int it = gw; it < 2 * PER_L; it += NGW) {
        const int l = it / PER_L; int r = it % PER_L;
        unsigned char* wl = a.ws + WS_W + (size_t)l * W_LAYER;
        if (r < I_IN) { transpose_item(a.w_in + (size_t)l * 1024 * INC, 1024, INC, (bf16*)(wl + WIN_OFF), 1, 0, scr, r, lane); continue; } r -= I_IN;
        if (r < I_P) { transpose_item(a.w_pg + (size_t)l * 512 * 1024, 512, 1024, (bf16*)(wl + WP_OFF), 0, 0, scr, r, lane); continue; } r -= I_P;
        if (r < I_P) { transpose_item(a.w_pr + (size_t)l * 512 * 1024, 512, 1024, (bf16*)(wl + WP_OFF), 0, 1024, scr, r, lane); continue; } r -= I_P;
        if (r < I_P) { transpose_item(a.w_pa + (size_t)l * 512 * 1024, 512, 1024, (bf16*)(wl + WP_OFF), 0, 2048, scr, r, lane); continue; } r -= I_P;
        if (r < I_O) { transpose_item(a.w_o + (size_t)l * 1024 * 1024, 1024, 1024, (bf16*)(wl + WO_OFF), 0, 0, scr, r, lane); continue; } r -= I_O;
        if (r < I_G) { transpose_item(a.w_gate + (size_t)l * 1024 * DFF, 1024, DFF, (bf16*)(wl + WGU_OFF), 2, 0, scr, r, lane); continue; } r -= I_G;
        if (r < I_G) { transpose_item(a.w_up + (size_t)l * 1024 * DFF, 1024, DFF, (bf16*)(wl + WGU_OFF), 3, 0, scr, r, lane); continue; } r -= I_G;
        transpose_item(a.w_down + (size_t)l * DFF * 1024, DFF, 1024, (bf16*)(wl + WD_OFF), 0, 0, scr, r, lane);
    }
    const int gt = obid() * 512 + tid, NGT = gridDim.x * 512;
    for (int i = gt; i < 2 * 31744; i += NGT) { const int l = i / 31744, j = i % 31744; ((u32x4*)(a.ws + WS_W + (size_t)l * W_LAYER + WIN_OFF + (size_t)7688 * 1024 * 2))[j] = (u32x4){0u, 0u, 0u, 0u}; }
    bf16* XB = (bf16*)(a.ws + WS_XB);
    for (int i = gt; i < T_ALL * DM / 4; i += NGT) { const f32x4 v = ((const f32x4*)a.x)[i]; u32x2 o; o.x = cvt_pk_bf16(v[0], v[1]); o.y = cvt_pk_bf16(v[2], v[3]); ((u32x2*)XB)[i] = o; }
}
__device__ __forceinline__ void ln_phase(float* X, const float* g, const float* b, bf16* XB) {
    const int tid = otid(), lane = tid & 63, wave = tid >> 6;
    const int gw = obid() * 8 + wave, NGW = gridDim.x * 8;
    for (int row = gw; row < T_ALL; row += NGW) {
        f32x4* xr = (f32x4*)(X + (size_t)row * DM) + lane;
        f32x4 v[4]; float s = 0.f;
#pragma unroll
        for (int j = 0; j < 4; ++j) { v[j] = xr[64 * j]; s += (v[j][0] + v[j][1]) + (v[j][2] + v[j][3]); }
        const float mean = wave_sum(s) * (1.f / DM); float s2 = 0.f;
#pragma unroll
        for (int j = 0; j < 4; ++j) { v[j] = v[j] - mean; s2 += (v[j][0] * v[j][0] + v[j][1] * v[j][1]) + (v[j][2] * v[j][2] + v[j][3] * v[j][3]); }
        const float rstd = 1.f / sqrtf(wave_sum(s2) * (1.f / DM) + 1e-5f);
        u32x2* o8 = (u32x2*)(XB + (size_t)row * DM) + lane;
#pragma unroll
        for (int j = 0; j < 4; ++j) { const f32x4 gg = ((const f32x4*)g)[lane + 64 * j], bb = ((const f32x4*)b)[lane + 64 * j]; const f32x4 o = v[j] * rstd * gg + bb;
            xr[64 * j] = o; u32x2 w; w.x = cvt_pk_bf16(o[0], o[1]); w.y = cvt_pk_bf16(o[2], o[3]); o8[64 * j] = w; }
    }
}
__device__ __forceinline__ void gmlp_phase(const Args& a, int l, LAS unsigned char* lds) {
    const int tid = otid(), lane = tid & 63, w = tid >> 6, fr = lane & 15, fq = lane >> 4;
    const bf16* H = (const bf16*)(a.ws + WS_H);
    bf16* YG = (bf16*)(a.ws + WS_Y);
    LAS bf16* Wl = (LAS bf16*)lds;
    LAS bf16* vT = (LAS bf16*)(lds + 34816);
    const float* lng = a.gln_g + l * 512; const float* lnb = a.gln_b + l * 512;
    const float* wsp = a.g_ws + (size_t)l * 4 * 128 * 128; const float* bsp = a.g_bs + l * 4 * 128;
    for (int u = obid(); u < 512; u += gridDim.x) {
        const int g = u & 3, n = (u >> 2) & 31, bl = u >> 7;
        const int r0 = bl * SEQ + n * 128;
        for (int i = 0; i < 16; ++i) {
            const int row = w * 16 + i;
            const u32x4 raw = *(const u32x4*)(H + (size_t)(r0 + row) * HP + C_GV + lane * 8);
            float f[8] = {bflo(raw.x), bfhi(raw.x), bflo(raw.y), bfhi(raw.y), bflo(raw.z), bfhi(raw.z), bflo(raw.w), bfhi(raw.w)};
            float s = 0.f;
#pragma unroll
            for (int e = 0; e < 8; ++e) s += f[e];
            const float mean = wave_sum(s) * (1.f / 512.f); float s2 = 0.f;
#pragma unroll
            for (int e = 0; e < 8; ++e) { f[e] -= mean; s2 += f[e] * f[e]; }
            const float rstd = 1.f / sqrtf(wave_sum(s2) * (1.f / 512.f) + 1e-5f);
            if ((lane >> 4) == g) { const int c0 = (lane & 15) * 8;
#pragma unroll
                for (int e = 0; e < 8; ++e) vT[(c0 + e) * 136 + row] = f2bf(f[e] * rstd * lng[g * 128 + c0 + e] + lnb[g * 128 + c0 + e]); }
        }
        { const int t = tid >> 2, seg = (tid & 3) * 32; const float* wp = wsp + (size_t)(g * 128 + t) * 128 + seg;
#pragma unroll
            for (int j = 0; j < 4; ++j) { const f32x4 x0 = *(const f32x4*)(wp + 8 * j), x1 = *(const f32x4*)(wp + 8 * j + 4); const int s0 = seg + 8 * j;
                u32x4 o; o.x = cvt_pk_bf16(s0 + 0 <= t ? x0[0] : 0.f, s0 + 1 <= t ? x0[1] : 0.f); o.y = cvt_pk_bf16(s0 + 2 <= t ? x0[2] : 0.f, s0 + 3 <= t ? x0[3] : 0.f);
                o.z = cvt_pk_bf16(s0 + 4 <= t ? x1[0] : 0.f, s0 + 5 <= t ? x1[1] : 0.f); o.w = cvt_pk_bf16(s0 + 6 <= t ? x1[2] : 0.f, s0 + 7 <= t ? x1[3] : 0.f);
                *(LAS u32x4*)(Wl + t * 136 + s0) = o; } }
        __syncthreads();
        f32x4 acc[8];
#pragma unroll
        for (int cb = 0; cb < 8; ++cb) acc[cb] = (f32x4){0.f, 0.f, 0.f, 0.f};
        const int nsb = (w >> 1) + 1;
        for (int sb = 0; sb < nsb; ++sb) {
            const bf16x8 tf = *(const LAS bf16x8*)(Wl + (16 * w + fr) * 136 + 32 * sb + 8 * fq);
#pragma unroll
            for (int cb = 0; cb < 8; ++cb) { const bf16x8 cf = *(const LAS bf16x8*)(vT + (16 * cb + fr) * 136 + 32 * sb + 8 * fq); acc[cb] = mfma16(cf, tf, acc[cb]); }
        }
        { const int t = 16 * w + fr; const float bsv = bsp[g * 128 + t]; const size_t hrow = (size_t)(r0 + t);
#pragma unroll
            for (int cb = 0; cb < 8; ++cb) { const int c = g * 128 + 16 * cb + 4 * fq; const u32x2 ur = *(const u32x2*)(H + hrow * HP + C_GU + c);
                u32x2 o; o.x = cvt_pk_bf16(bflo(ur.x) * (acc[cb][0] + bsv), bfhi(ur.x) * (acc[cb][1] + bsv)); o.y = cvt_pk_bf16(bflo(ur.y) * (acc[cb][2] + bsv), bfhi(ur.y) * (acc[cb][3] + bsv));
                *(u32x2*)(YG + hrow * 512 + c) = o; } }
        __syncthreads();
    }
}
__device__ __forceinline__ void fprep_phase(const Args& a, int l) {
    const int tid = otid(), lane = tid & 63, w = tid >> 6;
    const bf16* H = (const bf16*)(a.ws + WS_H);
    float* GF = (float*)(a.ws + WS_GF);
    for (int u = (int)gridDim.x - 1 - obid(); u < 4; u += gridDim.x) {
        const float fb = a.fox_fb[l * 8 + w];
        const bf16* p = H + (size_t)(u * SEQ + lane * 64) * HP + C_AF + w;
        float ls[64]; float run = 0.f;
#pragma unroll
        for (int i = 0; i < 64; ++i) { const float z = bf2f(p[(size_t)i * HP]) + fb; ls[i] = fminf(z, 0.f) - log1pf(__expf(-fabsf(z))); run += ls[i]; }
        float incl = run;
#pragma unroll
        for (int o = 1; o < 64; o <<= 1) { const float t = __shfl_up(incl, o); if (lane >= o) incl += t; }
        float acc = incl - run;
        float* gp = GF + (size_t)(u * 8 + w) * SEQ + lane * 64;
#pragma unroll
        for (int i = 0; i < 64; ++i) { acc += ls[i]; gp[i] = acc * LOG2E; }
    }
}
__device__ __forceinline__ void hgrn_gates(const bf16* Hz, float lb, int col, int part, LAS float* PS, float (&kk)[16], float (&cum)[16], float& last, float& rmid) {
    float run = 0.f; const float lbf = fmaxf(lb, 1e-30f), omlb = 1.f - lb;
#pragma unroll
    for (int i = 0; i < 16; ++i) { const float z = bf2f(Hz[(size_t)(16 * part + i) * HP + col]); const float sg = 1.f / (1.f + __expf(-z)), sgn = 1.f / (1.f + __expf(z));
        const float lf = logf(lbf + omlb * sg); kk[i] = omlb * sgn; run += lf; cum[i] = run; }
    PS[part * 128 + col] = run; __syncthreads();
    const float p0 = PS[col], p1 = PS[128 + col], p2 = PS[256 + col], p3 = PS[384 + col];
    const float prefix = (part > 0 ? p0 : 0.f) + (part > 1 ? p1 : 0.f) + (part > 2 ? p2 : 0.f);
    last = (p0 + p1) + (p2 + p3); rmid = p0 + p1;
#pragma unroll
    for (int i = 0; i < 16; ++i) cum[i] += prefix;
}
__device__ __forceinline__ float hgrn_lb(const Args& a, int l, int j) { if (l == 0) return 0.f; return 1.f / (1.f + __expf(a.lb_logits[j] - a.lb_logits[512 + j])); }
__device__ __forceinline__ void hgrn1_phase(const Args& a, int l, LAS unsigned char* lds) {
    const int tid = otid(), lane = tid & 63, w = tid >> 6, fr = lane & 15, fq = lane >> 4, col = tid & 127, part = tid >> 7;
    const bf16* H = (const bf16*)(a.ws + WS_H);
    bf16* U = (bf16*)(a.ws + WS_U); float* DEC = (float*)(a.ws + WS_DEC);
    LAS bf16* KT = (LAS bf16*)lds;
    LAS bf16* VT = (LAS bf16*)(lds + 18432);
    LAS float* PS = (LAS float*)(lds + 36864);
    for (int u = obid(); u < 1024; u += gridDim.x) {
        const int c = u & 63, h = (u >> 6) & 3, bl = u >> 8; const int s0 = bl * SEQ + c * 64;
        const float lb = hgrn_lb(a, l, h * 128 + col);
        float kk[16], cum[16], last, rmid;
        hgrn_gates(H + (size_t)s0 * HP + C_RF + h * 128, lb, col, part, PS, kk, cum, last, rmid);
#pragma unroll
        for (int i = 0; i < 16; ++i) { const int s = 16 * part + i; KT[col * 72 + s] = f2bf(kk[i] * __expf(last - cum[i])); VT[col * 72 + s] = H[(size_t)(s0 + s) * HP + C_RI + h * 128 + col]; }
        const size_t ci = (size_t)((bl * 4 + h) * 64 + c);
        if (part == 0) DEC[ci * 128 + col] = __expf(last);
        __syncthreads();
        bf16x8 vf[2];
#pragma unroll
        for (int ks = 0; ks < 2; ++ks) vf[ks] = *(const LAS bf16x8*)(VT + (16 * w + fr) * 72 + 32 * ks + 8 * fq);
#pragma unroll
        for (int kb = 0; kb < 8; ++kb) { f32x4 acc = (f32x4){0.f, 0.f, 0.f, 0.f};
#pragma unroll
            for (int ks = 0; ks < 2; ++ks) { const bf16x8 kf = *(const LAS bf16x8*)(KT + (16 * kb + fr) * 72 + 32 * ks + 8 * fq); acc = mfma16(kf, vf[ks], acc); }
            u32x2 o; o.x = cvt_pk_bf16(acc[0], acc[1]); o.y = cvt_pk_bf16(acc[2], acc[3]);
            *(u32x2*)(U + (ci * 128 + 16 * w + fr) * 128 + 16 * kb + 4 * fq) = o; }
        __syncthreads();
    }
}
__device__ __forceinline__ void hgrn2_phase(const Args& a) {
    unsigned* U = (unsigned*)(a.ws + WS_U); const float* DEC = (const float*)(a.ws + WS_DEC);
    for (int p = obid() * 512 + otid(); p < 131072; p += gridDim.x * 512) {
        const int bh = p >> 13, e2 = p & 8191, k = (e2 * 2) & 127;
        unsigned* up = U + (size_t)bh * 64 * 8192 + e2; const float* dp = DEC + (size_t)bh * 64 * 128 + k;
        float s0 = 0.f, s1 = 0.f;
#pragma unroll 8
        for (int c = 0; c < 64; ++c) { const unsigned uv = up[(size_t)c * 8192]; const float d0 = dp[c * 128], d1 = dp[c * 128 + 1]; up[(size_t)c * 8192] = cvt_pk_bf16(s0, s1); s0 = d0 * s0 + bflo(uv); s1 = d1 * s1 + bfhi(uv); }
    }
}
__device__ __forceinline__ void hgrn3_phase(const Args& a, int l, LAS unsigned char* lds) {
    const int tid = otid(), lane = tid & 63, w = tid >> 6, fr = lane & 15, fq = lane >> 4, col = tid & 127, part = tid >> 7;
    const bf16* H = (const bf16*)(a.ws + WS_H);
    const bf16* U = (const bf16*)(a.ws + WS_U);
    bf16* YR = (bf16*)(a.ws + WS_Y) + (size_t)TH * 512;
    LAS bf16* QI = (LAS bf16*)lds;
    LAS bf16* QH = (LAS bf16*)(lds + 17408);
    LAS bf16* KH = (LAS bf16*)(lds + 34816);
    LAS bf16* VT = (LAS bf16*)(lds + 52224);
    LAS bf16* SC = (LAS bf16*)(lds + 70656);
    LAS float* PS = (LAS float*)(lds + 79872);
    LAS float* RS = (LAS float*)(lds + 81920);
    const float* nw = a.r_norm_w + l * 128;
    for (int u = obid(); u < 1024; u += gridDim.x) {
        const int c = u & 63, h = (u >> 6) & 3, bl = u >> 8; const int s0 = bl * SEQ + c * 64;
        const float lb = hgrn_lb(a, l, h * 128 + col);
        float kk[16], cum[16], last, rmid;
        hgrn_gates(H + (size_t)s0 * HP + C_RF + h * 128, lb, col, part, PS, kk, cum, last, rmid);
#pragma unroll
        for (int i = 0; i < 16; ++i) { const int s = 16 * part + i; const size_t hr = (size_t)(s0 + s) * HP + h * 128 + col;
            const float q = bf2f(H[hr + C_RQ]);
            QI[s * 136 + col] = f2bf(q * __expf(cum[i])); QH[s * 136 + col] = f2bf(q * __expf(cum[i] - rmid)); KH[s * 136 + col] = f2bf(kk[i] * __expf(rmid - cum[i]));
            VT[col * 72 + s] = H[hr + C_RI]; }
        __syncthreads();
        const int tb = w & 3, hw = w >> 2;
#pragma unroll
        for (int j = 0; j < 2; ++j) { const int sb = 2 * hw + j; f32x4 acc = (f32x4){0.f, 0.f, 0.f, 0.f};
            if (sb <= tb) {
#pragma unroll
                for (int ks = 0; ks < 4; ++ks) { const bf16x8 kf = *(const LAS bf16x8*)(KH + (16 * sb + fr) * 136 + 32 * ks + 8 * fq), qf = *(const LAS bf16x8*)(QH + (16 * tb + fr) * 136 + 32 * ks + 8 * fq); acc = mfma16(kf, qf, acc); }
            }
            const int t = 16 * tb + fr, sbase = 16 * sb + 4 * fq;
            u32x2 o; o.x = cvt_pk_bf16(sbase + 0 <= t ? acc[0] : 0.f, sbase + 1 <= t ? acc[1] : 0.f); o.y = cvt_pk_bf16(sbase + 2 <= t ? acc[2] : 0.f, sbase + 3 <= t ? acc[3] : 0.f);
            *(LAS u32x2*)(SC + t * 72 + sbase) = o; }
        __syncthreads();
        const size_t ci = (size_t)((bl * 4 + h) * 64 + c);
        f32x4 o4[4]; float ssq = 0.f;
        { bf16x8 sf[2], qf[4];
#pragma unroll
            for (int ks = 0; ks < 2; ++ks) sf[ks] = *(const LAS bf16x8*)(SC + (16 * tb + fr) * 72 + 32 * ks + 8 * fq);
#pragma unroll
            for (int ks = 0; ks < 4; ++ks) qf[ks] = *(const LAS bf16x8*)(QI + (16 * tb + fr) * 136 + 32 * ks + 8 * fq);
#pragma unroll
            for (int nb = 0; nb < 4; ++nb) { const int vb = hw * 64 + nb * 16; f32x4 acc = (f32x4){0.f, 0.f, 0.f, 0.f};
#pragma unroll
                for (int ks = 0; ks < 2; ++ks) { const bf16x8 vf = *(const LAS bf16x8*)(VT + (vb + fr) * 72 + 32 * ks + 8 * fq); acc = mfma16(vf, sf[ks], acc); }
#pragma unroll
                for (int ks = 0; ks < 4; ++ks) { const bf16x8 uf = *(const bf16x8*)(U + (ci * 128 + vb + fr) * 128 + 32 * ks + 8 * fq); acc = mfma16(uf, qf[ks], acc); }
                o4[nb] = acc; ssq += (acc[0] * acc[0] + acc[1] * acc[1]) + (acc[2] * acc[2] + acc[3] * acc[3]); } }
        ssq += __shfl_xor(ssq, 16); ssq += __shfl_xor(ssq, 32);
        if (fq == 0) RS[hw * 64 + 16 * tb + fr] = ssq;
        __syncthreads();
        { const int t = 16 * tb + fr; const float rstd = 1.f / sqrtf((RS[t] + RS[64 + t]) * (1.f / 128.f) + 1e-6f); const size_t hrow = (size_t)(s0 + t);
#pragma unroll
            for (int nb = 0; nb < 4; ++nb) { const int v = hw * 64 + nb * 16 + 4 * fq; const u32x2 gr = *(const u32x2*)(H + hrow * HP + C_RG + h * 128 + v); const f32x4 nv = *(const f32x4*)(nw + v);
                const float g0 = bflo(gr.x), g1 = bfhi(gr.x), g2 = bflo(gr.y), g3 = bfhi(gr.y);
                u32x2 o; o.x = cvt_pk_bf16(o4[nb][0] * rstd * nv[0] * g0 * sigm(g0), o4[nb][1] * rstd * nv[1] * g1 * sigm(g1)); o.y = cvt_pk_bf16(o4[nb][2] * rstd * nv[2] * g2 * sigm(g2), o4[nb][3] * rstd * nv[3] * g3 * sigm(g3));
                *(u32x2*)(YR + hrow * 512 + h * 128 + v) = o; } }
        __syncthreads();
    }
}
__device__ __forceinline__ int crow(int r, int hi) { return (r & 3) + 8 * (r >> 2) + 4 * hi; }
__device__ __forceinline__ void attn_unit(const Args& a, int bl, int h, int qb, LAS unsigned char* lds) {
    const int tid = otid(), lane = tid & 63, w = tid >> 6, r32 = lane & 31, hi = lane >> 5;
    const bf16* H = (const bf16*)(a.ws + WS_H);
    const float* G = (const float*)(a.ws + WS_GF) + (size_t)(bl * 8 + h) * SEQ;
    bf16* YA = (bf16*)(a.ws + WS_Y) + (size_t)2 * TH * 512;
    LAS bf16* Ks = (LAS bf16*)lds;
    LAS bf16* VT = (LAS bf16*)(lds + 9216);
    LAS float* Gs = (LAS float*)(lds + 18432);
    const size_t rowbase = (size_t)bl * SEQ;
    const int q0 = qb * 256 + w * 32;
    bf16x8 qr[4];
#pragma unroll
    for (int d0 = 0; d0 < 4; ++d0) qr[d0] = *(const bf16x8*)(H + (rowbase + q0 + r32) * HP + C_AQ + h * 64 + d0 * 16 + hi * 8);
    const float Gq = G[q0 + r32];
    float m = -1e30f, lsum = 0.f; f32x16 oT[2];
#pragma unroll
    for (int r = 0; r < 16; ++r) { oT[0][r] = 0.f; oT[1][r] = 0.f; }
    const int NT = 4 * qb + 4;
    const int kvr = tid >> 3, ch = tid & 7;
    const int kvp = (kvr & ~12) | ((kvr & 4) << 1) | ((kvr & 8) >> 1);
    const bf16* kp = H + (rowbase + kvr) * HP + C_AK + h * 64 + ch * 8;
    const bf16* vp = H + (rowbase + kvr) * HP + C_AV + h * 64 + ch * 8;
    u32x4 kreg = *(const u32x4*)kp, vreg = *(const u32x4*)vp; float greg = (tid < 64) ? G[tid] : 0.f;
    for (int t = 0; t < NT; ++t) {
        __syncthreads();
        *(LAS u32x4*)(Ks + kvr * 72 + ch * 8) = kreg;
        { LAS bf16* vd = VT + (ch * 8) * 72 + kvp;
          vd[0 * 72] = (bf16)(vreg.x & 0xffffu); vd[1 * 72] = (bf16)(vreg.x >> 16); vd[2 * 72] = (bf16)(vreg.y & 0xffffu); vd[3 * 72] = (bf16)(vreg.y >> 16);
          vd[4 * 72] = (bf16)(vreg.z & 0xffffu); vd[5 * 72] = (bf16)(vreg.z >> 16); vd[6 * 72] = (bf16)(vreg.w & 0xffffu); vd[7 * 72] = (bf16)(vreg.w >> 16); }
        if (tid < 64) Gs[tid] = greg;
        __syncthreads();
        if (t + 1 < NT) { kreg = *(const u32x4*)(kp + (size_t)(t + 1) * 64 * HP); vreg = *(const u32x4*)(vp + (size_t)(t + 1) * 64 * HP); if (tid < 64) greg = G[(t + 1) * 64 + tid]; }
        const int kv0 = 64 * t;
        if (kv0 > q0 + 31) continue;
        f32x16 p0, p1;
#pragma unroll
        for (int r = 0; r < 16; ++r) { p0[r] = 0.f; p1[r] = 0.f; }
#pragma unroll
        for (int d0 = 0; d0 < 4; ++d0) { const bf16x8 k0 = *(const LAS bf16x8*)(Ks + r32 * 72 + d0 * 16 + hi * 8), k1 = *(const LAS bf16x8*)(Ks + (32 + r32) * 72 + d0 * 16 + hi * 8);
            p0 = mfma32(k0, qr[d0], p0); p1 = mfma32(k1, qr[d0], p1); }
#pragma unroll
        for (int rg = 0; rg < 4; ++rg) { const f32x4 g0 = *(const LAS f32x4*)(Gs + 8 * rg + 4 * hi), g1 = *(const LAS f32x4*)(Gs + 32 + 8 * rg + 4 * hi);
#pragma unroll
            for (int e = 0; e < 4; ++e) { p0[4 * rg + e] += Gq - g0[e]; p1[4 * rg + e] += Gq - g1[e]; } }
        if (kv0 + 63 > q0) { const int q = q0 + r32;
#pragma unroll
            for (int r = 0; r < 16; ++r) { const int kv = kv0 + crow(r, hi); if (kv > q) p0[r] = -1e30f; if (kv + 32 > q) p1[r] = -1e30f; } }
        float mx = fmaxf(p0[0], p1[0]);
#pragma unroll
        for (int r = 1; r < 16; ++r) mx = fmaxf(mx, fmaxf(p0[r], p1[r]));
        mx = fmaxf(mx, __shfl_xor(mx, 32));
        const float mnew = fmaxf(m, mx), alpha = __builtin_amdgcn_exp2f(m - mnew); m = mnew;
        float rs = 0.f;
#pragma unroll
        for (int r = 0; r < 16; ++r) { p0[r] = __builtin_amdgcn_exp2f(p0[r] - mnew); p1[r] = __builtin_amdgcn_exp2f(p1[r] - mnew); rs += p0[r] + p1[r]; }
        lsum = lsum * alpha + rs;
#pragma unroll
        for (int r = 0; r < 16; ++r) { oT[0][r] *= alpha; oT[1][r] *= alpha; }
        u32x4 pw[4];
#pragma unroll
        for (int j = 0; j < 2; ++j) { pw[j] = (u32x4){cvt_pk_bf16(p0[8 * j + 0], p0[8 * j + 1]), cvt_pk_bf16(p0[8 * j + 2], p0[8 * j + 3]), cvt_pk_bf16(p0[8 * j + 4], p0[8 * j + 5]), cvt_pk_bf16(p0[8 * j + 6], p0[8 * j + 7])};
            pw[2 + j] = (u32x4){cvt_pk_bf16(p1[8 * j + 0], p1[8 * j + 1]), cvt_pk_bf16(p1[8 * j + 2], p1[8 * j + 3]), cvt_pk_bf16(p1[8 * j + 4], p1[8 * j + 5]), cvt_pk_bf16(p1[8 * j + 6], p1[8 * j + 7])}; }
#pragma unroll
        for (int dh = 0; dh < 2; ++dh)
#pragma unroll
            for (int j = 0; j < 4; ++j) { const bf16x8 vf = *(const LAS bf16x8*)(VT + (dh * 32 + r32) * 72 + 16 * j + 8 * hi); oT[dh] = mfma32(vf, __builtin_bit_cast(bf16x8, pw[j]), oT[dh]); }
    }
    lsum += __shfl_xor(lsum, 32);
    const float inv = 1.f / lsum;
    bf16* op = YA + (rowbase + q0 + r32) * 512 + h * 64;
#pragma unroll
    for (int dh = 0; dh < 2; ++dh)
#pragma unroll
        for (int rg = 0; rg < 4; ++rg) { u32x2 o; o.x = cvt_pk_bf16(oT[dh][4 * rg + 0] * inv, oT[dh][4 * rg + 1] * inv); o.y = cvt_pk_bf16(oT[dh][4 * rg + 2] * inv, oT[dh][4 * rg + 3] * inv);
            *(u32x2*)(op + dh * 32 + 8 * rg + 4 * hi) = o; }
}
__device__ __forceinline__ void attn_phase(const Args& a, LAS unsigned char* lds) {
    const int G = gridDim.x, bx = obid();
    const int vcu0 = (G % 8 == 0) ? (bx % 8) * (G / 8) + bx / 8 : bx;
    for (int v = vcu0; v < 256; v += G) { const int bh = v >> 3, s = v & 7;
        attn_unit(a, bh >> 3, bh & 7, 15 - s, lds); attn_unit(a, bh >> 3, bh & 7, s, lds); }
}
#ifndef PH_MASK
#define PH_MASK 0xffff
#endif
#define PHON(k) ((PH_MASK >> (k)) & 1)
__device__ __forceinline__ void run_phase(const Args& a, int p, LAS unsigned char* lds) {
    if (p == 0) { if (PHON(0)) prep_phase(a, lds); return; }
    const int l = (p - 1) >> 4, q = (p - 1) & 15;
    unsigned char* wl = a.ws + WS_W + (size_t)l * W_LAYER;
    bf16* XB = (bf16*)(a.ws + WS_XB); bf16* Hh = (bf16*)(a.ws + WS_H); bf16* Y = (bf16*)(a.ws + WS_Y); bf16* MB = (bf16*)(a.ws + WS_MB);
    const float alpha = 1.4142135623730951f;
    if (q < 12) {
        const int hb = q / 6, s = q % 6;
        if (s == 0) { if (PHON(1)) { pg8::Gemm g{XB + (size_t)hb * TH * DM, (const bf16*)(wl + WIN_OFF), TH, HP, DM}; pg8::StaticOrder S; S.init(TH, HP, gridDim.x, obid());
            pg8::EpiH E{Hh}; pg8::gemm_phase<pg8::EpiH, pg8::StaticOrder, PG8_ALIGN, PG8_SP2>(lds, g, S, E); } }
        else if (s == 1) { if (PHON(2)) gmlp_phase(a, l, lds); if (PHON(3)) fprep_phase(a, l); if (PHON(4)) hgrn1_phase(a, l, lds); }
        else if (s == 2) { if (PHON(5)) hgrn2_phase(a); if (PHON(6)) attn_phase(a, lds); }
        else if (s == 3) { if (PHON(7)) hgrn3_phase(a, l, lds); }
        else if (s == 4) { if (PHON(8)) { pg8::Gemm g{Y, (const bf16*)(wl + WP_OFF), 3 * TH, 3 * DM, 512}; pg8::ProjOrder S{(int)gridDim.x, obid()};
            pg8::EpiProj E{Hh, MB}; pg8::gemm_phase<pg8::EpiProj, pg8::ProjOrder, PG8_ALIGN, PG8_SP2>(lds, g, S, E); } }
        else { if (PHON(9)) { pg8::Gemm g{MB, (const bf16*)(wl + WO_OFF), TH, DM, DM}; pg8::StaticOrder S; S.init(TH, DM, gridDim.x, obid());
            const float* base = (l == 0 ? a.x : a.out) + (size_t)hb * TH * DM;
            pg8::EpiResid E{base, a.out + (size_t)hb * TH * DM, alpha}; pg8::gemm_phase<pg8::EpiResid, pg8::StaticOrder, PG8_ALIGN, PG8_SP2>(lds, g, S, E); } }
        return;
    }
    if (q == 12) { if (PHON(10)) ln_phase(a.out, a.ln1_g + l * DM, a.ln1_b + l * DM, XB); return; }
    if (q == 13) { if (PHON(11)) { pg8::Gemm g{XB, (const bf16*)(wl + WGU_OFF), T_ALL, 2 * DFF, DM}; pg8::StaticOrder S; S.init(T_ALL, 2 * DFF, gridDim.x, obid());
        pg8::EpiSwiglu E{Hh}; pg8::gemm_phase<pg8::EpiSwiglu, pg8::StaticOrder, PG8_ALIGN, PG8_SP2>(lds, g, S, E); } return; }
    if (q == 14) { if (PHON(12)) { pg8::Gemm g{Hh, (const bf16*)(wl + WD_OFF), T_ALL, DM, DFF}; pg8::StaticOrder S; S.init(T_ALL, DM, gridDim.x, obid());
        pg8::EpiResid E{a.out, a.out, alpha}; pg8::gemm_phase<pg8::EpiResid, pg8::StaticOrder, PG8_ALIGN, PG8_SP2>(lds, g, S, E); } return; }
    if (PHON(10)) ln_phase(a.out, a.ln2_g + l * DM, a.ln2_b + l * DM, XB);
}
__global__ void __launch_bounds__(512, 2) mega(Args a) {
    extern __shared__ __attribute__((aligned(16))) unsigned char lds_raw[];
    LAS unsigned char* lds = (LAS unsigned char*)lds_raw;
    cg::grid_group grid = cg::this_grid();
    for (int p = a.lo; p < a.hi; ++p) {
        Args b = a; asm volatile("" : "+s"(b.ws), "+s"(b.out));
        run_phase(b, p, lds);
        if (p + 1 < a.hi) grid.sync();
    }
}

#ifndef MK_DEBUG
#define MK_DEBUG 0
#endif
#if MK_DEBUG
__global__ void __launch_bounds__(256) dbg_check(const unsigned* base, size_t nwords, int type, unsigned long long* ctl, int p, int rep, int r) {
    unsigned long long cs = 0ull, nf = 0ull;
    for (size_t i = (size_t)blockIdx.x * 256 + threadIdx.x; i < nwords; i += (size_t)gridDim.x * 256) { const unsigned w = base[i];
        cs += (unsigned long long)w * (2ull * i + 1ull);
        if (type == 1) { if ((w & 0x7f800000u) >= (141u << 23)) ++nf; } else { if ((w & 0x7f80u) >= (141u << 7)) ++nf; if ((w & 0x7f800000u) >= (141u << 23)) ++nf; } }
    for (int o = 1; o < 64; o <<= 1) { cs += __shfl_xor(cs, o); nf += __shfl_xor(nf, o); }
    if ((threadIdx.x & 63) == 0) { atomicAdd(ctl + 64 + (rep * 64 + p) * 4 + r, cs); if (nf) atomicAdd(ctl + p, nf); }
}
__global__ void __launch_bounds__(256) dbg_report(const unsigned long long* ctl, float* out, size_t n) {
    int code = 0;
    if (ctl[40]) code = 90;
    for (int p = 0; p < NPHASE && !code; ++p) { if (ctl[p]) code = 3 + p; else for (int r = 0; r < 4; ++r) if (ctl[64 + p * 4 + r] != ctl[64 + (64 + p) * 4 + r]) code = 40 + p; }
    if (!code) return;
    for (size_t i = (size_t)blockIdx.x * 256 + threadIdx.x; i < n; i += (size_t)gridDim.x * 256) out[i] = (float)code;
}
__global__ void __launch_bounds__(256) dbg_g1(const float* w_in, const unsigned char* ws, unsigned long long* ctl, int hb) {
    const unsigned hsh = (blockIdx.x + 1u) * 2654435761u; const int row = (hsh >> 8) % TH; const int n = 1024 + (int)((hsh * 40503u >> 4) % (INC - 1024));
    const bf16* XB = (const bf16*)(ws + WS_XB) + ((size_t)hb * TH + row) * DM; const bf16* H = (const bf16*)(ws + WS_H);
    float s = 0.f; for (int k = threadIdx.x; k < DM; k += 256) s += bf2f(XB[k]) * w_in[(size_t)k * INC + n];
    __shared__ float red[256]; red[threadIdx.x] = s; __syncthreads();
    if (threadIdx.x == 0) { float t = 0.f; for (int i = 0; i < 256; ++i) t += red[i]; if (n >= 3072 && n < 3584) t *= pg8::QSCALE;
        const float got = bf2f(H[(size_t)row * HP + rowmap(1, n)]); if (!(fabsf(got - t) <= 0.03f + 0.03f * fabsf(t))) atomicAdd(ctl + 40, 1ull); }
}
struct DbgReg { size_t off; size_t bytes; int type; int in_out; };
static int dbg_regions(int p, DbgReg* R) {
    if (p == 0) { R[0] = {WS_W, WS_H - WS_W, 0, 0}; return 1; }
    const int q = (p - 1) & 15;
    if (q < 12) { const int hb = q / 6, s = q % 6;
        if (s == 0) { R[0] = {WS_H, 248 * MiB, 0, 0}; return 1; }
        if (s == 1) { R[0] = {WS_Y, 16 * MiB, 0, 0}; R[1] = {WS_U, 32 * MiB, 0, 0}; R[2] = {WS_DEC, 1 * MiB, 1, 0}; return 3; }
        if (s == 2) { R[0] = {WS_U, 32 * MiB, 0, 0}; R[1] = {WS_Y + 32 * MiB, 16 * MiB, 0, 0}; return 2; }
        if (s == 3) { R[0] = {WS_Y + 16 * MiB, 16 * MiB, 0, 0}; return 1; }
        if (s == 4) { R[0] = {WS_MB, 32 * MiB, 0, 0}; return 1; }
        R[0] = {(size_t)hb * 64 * MiB, 64 * MiB, 1, 1}; return 1; }
    if (q == 13) { R[0] = {WS_H, 176 * MiB, 0, 0}; return 1; }
    if (q == 14) { R[0] = {0, 128 * MiB, 1, 1}; return 1; }
    R[0] = {0, 128 * MiB, 1, 1}; R[1] = {WS_XB, 64 * MiB, 0, 0}; return 2;
}
#endif
#ifndef MK_MULTI
#define MK_MULTI 0
#endif
extern "C" void kernel_launch(void* const* d_in, const int* in_sizes, int n_in, void* d_out, int out_size, void* d_ws, size_t ws_size, hipStream_t stream) {
    static int grid = 0;
    if (grid == 0) {
        if (n_in != 20 || out_size != T_ALL * DM || ws_size < WS_END) { fprintf(stderr, "kernel_launch: unexpected shapes (n_in %d out %d ws %zu)\n", n_in, out_size, ws_size); grid = -1; return; }
        if (hipFuncSetAttribute((const void*)mega, hipFuncAttributeMaxDynamicSharedMemorySize, LDS_BYTES) != hipSuccess) { fprintf(stderr, "kernel_launch: hipFuncSetAttribute failed\n"); grid = -1; return; }
        int dev = 0, cus = 0, per_cu = 0;
        (void)hipGetDevice(&dev); (void)hipDeviceGetAttribute(&cus, hipDeviceAttributeMultiprocessorCount, dev);
        (void)hipOccupancyMaxActiveBlocksPerMultiprocessor(&per_cu, (const void*)mega, 512, LDS_BYTES);
        if (per_cu < 1) per_cu = 1;
        grid = cus;
        (void)hipGetLastError();
    }
    if (grid < 0) return;
    Args a{};
    const float** ap = (const float**)&a;
    for (int i = 0; i < 20; ++i) ap[i] = (const float*)d_in[i];
    a.out = (float*)d_out; a.ws = (unsigned char*)d_ws;
#if MK_DEBUG
    (void)hipMemsetAsync(d_ws, 0xAA, WS_END, stream); (void)hipMemsetAsync(d_out, 0xAA, (size_t)T_ALL * DM * 4, stream); (void)hipMemsetAsync(d_ws, 0, 1 * MiB, stream);
    for (int rep = 0; rep < 2; ++rep)
        for (int p = 0; p < NPHASE; ++p) { a.lo = p; a.hi = p + 1; hipLaunchKernelGGL(mega, dim3(grid), dim3(512), LDS_BYTES, stream, a);
            if (p == 1 && rep == 0) hipLaunchKernelGGL(dbg_g1, dim3(2048), dim3(256), 0, stream, (const float*)d_in[1], (const unsigned char*)d_ws, (unsigned long long*)d_ws, 0);
            DbgReg R[4]; const int nr = dbg_regions(p, R);
            for (int r = 0; r < nr; ++r) hipLaunchKernelGGL(dbg_check, dim3(1024), dim3(256), 0, stream, (const unsigned*)((R[r].in_out ? (unsigned char*)d_out : (unsigned char*)d_ws) + R[r].off), R[r].bytes / 4, R[r].type, (unsigned long long*)d_ws, p, rep, r); }
    hipLaunchKernelGGL(dbg_report, dim3(1024), dim3(256), 0, stream, (const unsigned long long*)d_ws, (float*)d_out, (size_t)T_ALL * DM);
#elif MK_MULTI
    for (int p = 0; p < NPHASE; ++p) { a.lo = p; a.hi = p + 1; hipLaunchKernelGGL(mega, dim3(grid), dim3(512), LDS_BYTES, stream, a); }
#else
    a.lo = 0; a.hi = NPHASE;
    void* args[] = {&a};
    hipError_t e = hipLaunchCooperativeKernel((const void*)mega, dim3(grid), dim3(512), args, LDS_BYTES, stream);
    if (e != hipSuccess) fprintf(stderr, "cooperative launch failed: %s (grid %d)\n", hipGetErrorString(e), grid);
#endif
}
```

```cpp
#include <hip/hip_cooperative_groups.h>
#include <hip/hip_runtime.h>
#include <cstdio>
#include <cstdint>
__device__ __forceinline__ int otid() { int t = threadIdx.x; asm volatile("" : "+v"(t)); return t; }
__device__ __forceinline__ int obid() { int b = blockIdx.x; asm volatile("" : "+s"(b)); return b; }
namespace pg8 {
#define PG8_LAS __attribute__((address_space(3)))
typedef unsigned short bf16_t;
typedef short bf16x8 __attribute__((ext_vector_type(8)));
typedef float f32x4 __attribute__((ext_vector_type(4)));
typedef unsigned u32x4 __attribute__((ext_vector_type(4)));
constexpr int BM = 256, BK = 64, HALF = 128, HTB = HALF * BK * 2  , STAGE_BYTES = 8 * HTB, NXCD = 8, WGM = 8;

__host__ __device__ __forceinline__ int lds_byte(int r, int c) { const int st = (r >> 4) * 2 + (c >> 5), rr = r & 15, cc = c & 31, ob = rr * 64 + cc * 2; return st * 1024 + (ob ^ (((ob >> 9) & 1) << 5)); }
__host__ __device__ __forceinline__ void stage_rc(int b, int& R, int& C) { const int st = b / 1024, sb = b % 1024, swz = sb ^ (((sb >> 9) & 1) << 5); R = (st >> 1) * 16 + swz / 64; C = (st & 1) * 32 + (swz % 64) / 2; }
__host__ __device__ __forceinline__ int perm32(int rho) { const int n = rho >> 4, i = rho & 15; return 8 * (i >> 2) + 4 * n + (i & 3); }

struct Unit { int pm, pn; };
struct Gemm { const bf16_t* A; const bf16_t* Bt; int M, N, K; };

struct StaticOrder {
    int nM, nN, nwg, G, c;
    __host__ __device__ void init(int M, int N, int G_, int c_) { nM = M / BM; nN = N / BM; nwg = nM * nN; G = G_; c = c_; }
    __host__ __device__ bool next(int i, Unit& u) const {
        const long L = (long)i * G + c; if (L >= nwg) return false;
        int wgid = (int)L; { const int q = nwg / NXCD, r = nwg % NXCD, xcd = wgid % NXCD, off = wgid / NXCD; wgid = (xcd < r ? xcd * (q + 1) : r * (q + 1) + (xcd - r) * q) + off; }
        const int nig = WGM * nN, gid = wgid / nig, fm = gid * WGM, gsz = (nM - fm) < WGM ? (nM - fm) : WGM;
        u.pm = fm + ((wgid % nig) % gsz); u.pn = (wgid % nig) / gsz; return true;
    }
    __device__ __forceinline__ void a_ready(const Unit&) const {}
    __device__ __forceinline__ void done(const Unit&) const {}
};

typedef float f32x2c_t __attribute__((ext_vector_type(2))); typedef __bf16 bf16x2c_t __attribute__((ext_vector_type(2)));
__device__ __forceinline__ unsigned cvt_pk_bf16(float lo, float hi) { f32x2c_t v = {lo, hi}; bf16x2c_t b = __builtin_convertvector(v, bf16x2c_t); return __builtin_bit_cast(unsigned, b); }
typedef float f32x2 __attribute__((ext_vector_type(2)));
__device__ __forceinline__ f32x2 gelu_pk(f32x2 v) {
    const f32x2 av = __builtin_elementwise_abs(v), d = av * 0.2316418882f + 1.0f;
    f32x2 t; t.x = __builtin_amdgcn_rcpf(d.x); t.y = __builtin_amdgcn_rcpf(d.y);
    f32x2 q = t * 0.5307027145f + (-0.7265760135f); q = q * t + 0.7107068705f; q = q * t + (-0.142248368f); q = q * t + 0.127414796f; q = q * t;
    const f32x2 s = (v * v) * (-0.72134752044f);
    f32x2 e; e.x = __builtin_amdgcn_exp2f(s.x); e.y = __builtin_amdgcn_exp2f(s.y);
    const f32x2 m = v * (q * e), r = v - m;
    f32x2 o; o.x = v.x < 0.f ? m.x : r.x; o.y = v.y < 0.f ? m.y : r.y; return o;
}

constexpr int HPITCH = 7936;
constexpr float QSCALE = 0.125f * 1.4426950408889634f;
__device__ __forceinline__ float bflo(unsigned w) { return __uint_as_float(w << 16); }
__device__ __forceinline__ float bfhi(unsigned w) { return __uint_as_float(w & 0xffff0000u); }
__device__ __forceinline__ float sigm(float x) { return 1.0f / (1.0f + __expf(-x)); }
struct EpiH {
    static constexpr bool PERM = true, AFTER_DRAIN = false;
    bf16_t* O;
    __device__ __forceinline__ void operator()(const f32x4 (&acc)[2][2][4][2], const Unit& u, int wr, int wc, int fr, int fq) const {
        const int row0 = u.pm * BM + wr * 64 + fr; const int col0 = u.pn * BM + wc * 32 + 8 * fq;
        const bool dogelu = u.pn < 4; const float sc = (u.pn == 12 || u.pn == 13) ? QSCALE : 1.f;
#pragma unroll
        for (int ai = 0; ai < 2; ++ai)
#pragma unroll
            for (int m = 0; m < 4; ++m) { bf16_t* rowp = O + (size_t)(row0 + ai * HALF + m * 16) * HPITCH + col0;
#pragma unroll
                for (int bj = 0; bj < 2; ++bj) { f32x4 v0 = acc[ai][bj][m][0], v1 = acc[ai][bj][m][1];
                    if (dogelu) { f32x2 a = gelu_pk((f32x2){v0[0], v0[1]}), b = gelu_pk((f32x2){v0[2], v0[3]}), c = gelu_pk((f32x2){v1[0], v1[1]}), d = gelu_pk((f32x2){v1[2], v1[3]});
                        v0 = (f32x4){a.x, a.y, b.x, b.y}; v1 = (f32x4){c.x, c.y, d.x, d.y}; }
                    v0 = v0 * sc; v1 = v1 * sc; u32x4 w; w.x = cvt_pk_bf16(v0[0], v0[1]); w.y = cvt_pk_bf16(v0[2], v0[3]); w.z = cvt_pk_bf16(v1[0], v1[1]); w.w = cvt_pk_bf16(v1[2], v1[3]);
                    *(u32x4*)(rowp + bj * HALF) = w; } }
    }
};
struct EpiProj {
    static constexpr bool PERM = true, AFTER_DRAIN = false;
    const bf16_t* Hh; bf16_t* MB;
    __device__ __forceinline__ void operator()(const f32x4 (&acc)[2][2][4][2], const Unit& u, int wr, int wc, int fr, int fq) const {
        const int br = u.pn >> 2, pnn = u.pn & 3, pmm = u.pm & 63;
        const int row0 = pmm * BM + wr * 64 + fr; const int col0 = pnn * BM + wc * 32 + 8 * fq;
#pragma unroll
        for (int ai = 0; ai < 2; ++ai)
#pragma unroll
            for (int m = 0; m < 4; ++m) { const size_t row = (size_t)(row0 + ai * HALF + m * 16);
#pragma unroll
                for (int bj = 0; bj < 2; ++bj) { const int col = col0 + bj * HALF;
                    const u32x4 gw = *(const u32x4*)(Hh + row * HPITCH + 4608 + br * 1024 + col);
                    const f32x4 v0 = acc[ai][bj][m][0], v1 = acc[ai][bj][m][1];
                    float r0 = sigm(bflo(gw.x)) * v0[0], r1 = sigm(bfhi(gw.x)) * v0[1], r2 = sigm(bflo(gw.y)) * v0[2], r3 = sigm(bfhi(gw.y)) * v0[3];
                    float r4 = sigm(bflo(gw.z)) * v1[0], r5 = sigm(bfhi(gw.z)) * v1[1], r6 = sigm(bflo(gw.w)) * v1[2], r7 = sigm(bfhi(gw.w)) * v1[3];
                    bf16_t* mp = MB + row * 1024 + col;
                    if (br > 0) { const u32x4 o = *(const u32x4*)mp; r0 += bflo(o.x); r1 += bfhi(o.x); r2 += bflo(o.y); r3 += bfhi(o.y); r4 += bflo(o.z); r5 += bfhi(o.z); r6 += bflo(o.w); r7 += bfhi(o.w); }
                    u32x4 w; w.x = cvt_pk_bf16(r0, r1); w.y = cvt_pk_bf16(r2, r3); w.z = cvt_pk_bf16(r4, r5); w.w = cvt_pk_bf16(r6, r7);
                    *(u32x4*)mp = w; } }
    }
};
struct EpiResid {
    static constexpr bool PERM = false, AFTER_DRAIN = false;
    const float* base; float* out; float alpha;
    __device__ __forceinline__ void operator()(const f32x4 (&acc)[2][2][4][2], const Unit& u, int wr, int wc, int fr, int fq) const {
        const int row0 = u.pm * BM + wr * 64 + fr; const int col0 = u.pn * BM + wc * 32 + 4 * fq;
#pragma unroll
        for (int ai = 0; ai < 2; ++ai)
#pragma unroll
            for (int m = 0; m < 4; ++m) { const size_t off = (size_t)(row0 + ai * HALF + m * 16) * 1024 + col0;
#pragma unroll
                for (int bj = 0; bj < 2; ++bj)
#pragma unroll
                    for (int n = 0; n < 2; ++n) { const f32x4 b = *(const f32x4*)(base + off + bj * HALF + n * 16); *(f32x4*)(out + off + bj * HALF + n * 16) = b * alpha + acc[ai][bj][m][n]; } }
    }
};
struct EpiSwiglu {
    static constexpr bool PERM = true, AFTER_DRAIN = false;
    bf16_t* O;
    __device__ __forceinline__ void operator()(const f32x4 (&acc)[2][2][4][2], const Unit& u, int wr, int wc, int fr, int fq) const {
        const int row0 = u.pm * BM + wr * 64 + fr; const int col0 = u.pn * HALF + wc * 32 + 8 * fq;
#pragma unroll
        for (int ai = 0; ai < 2; ++ai)
#pragma unroll
            for (int m = 0; m < 4; ++m) { const f32x4 g0 = acc[ai][0][m][0], g1 = acc[ai][0][m][1], u0 = acc[ai][1][m][0], u1 = acc[ai][1][m][1];
                u32x4 w; w.x = cvt_pk_bf16(g0[0] * sigm(g0[0]) * u0[0], g0[1] * sigm(g0[1]) * u0[1]); w.y = cvt_pk_bf16(g0[2] * sigm(g0[2]) * u0[2], g0[3] * sigm(g0[3]) * u0[3]);
                w.z = cvt_pk_bf16(g1[0] * sigm(g1[0]) * u1[0], g1[1] * sigm(g1[1]) * u1[1]); w.w = cvt_pk_bf16(g1[2] * sigm(g1[2]) * u1[2], g1[3] * sigm(g1[3]) * u1[3]);
                *(u32x4*)(O + (size_t)(row0 + ai * HALF + m * 16) * 2816 + col0) = w; }
    }
};
struct ProjOrder {
    int G, c;
    __device__ __forceinline__ bool next(int i, Unit& u) const { const int tile = c + (i / 3) * G; if (tile >= 256) return false; const int br = i % 3; u.pm = br * 64 + (tile >> 2); u.pn = br * 4 + (tile & 3); return true; }
    __device__ __forceinline__ void a_ready(const Unit&) const {}
    __device__ __forceinline__ void done(const Unit&) const {}
};
template <class Epi, class Sched, bool ALIGN_EPI = false, bool SP2 = false>
__device__ __forceinline__ void gemm_phase(PG8_LAS unsigned char* lds, const Gemm g, const Sched& S, const Epi& E) {
    const int tid = otid(), wid = __builtin_amdgcn_readfirstlane(tid >> 6), lane = tid & 63, wr = wid >> 2, wc = wid & 3, fr = lane & 15, fq = lane >> 4;
    const int K = g.K, nt = K / BK;
    unsigned voffA[2], voffB[2];
#pragma unroll
    for (int i = 0; i < 2; ++i) { int R, C; stage_rc(tid * 16 + i * 8192, R, C); const int Rb = Epi::PERM ? ((R & ~31) + perm32(R & 31)) : R;
        voffA[i] = (unsigned)(R * K + C) * 2u; voffB[i] = (unsigned)(Rb * K + C) * 2u; }
    const size_t kstep = (size_t)(BK * 2);
    const size_t hstep = (size_t)HALF * K * 2;
    const size_t tstep = 2 * hstep;
    const unsigned ldsw = (unsigned)wid * 1024u;
    const int aoff = lds_byte(wr * 64 + fr, fq * 8), boff = lds_byte(wc * 32 + fr, fq * 8);
#define PG8_SA(b, h) (((b) * 2 + (h)) * HTB)
#define PG8_SB(b, h) ((4 + (b) * 2 + (h)) * HTB)
#define PG8_STAGE(bufoff, gbase, voff) do { _Pragma("unroll") for (int _i = 0; _i < 2; ++_i) \
        __builtin_amdgcn_global_load_lds((const unsigned*)((const char*)(gbase) + (voff)[_i]), (PG8_LAS unsigned*)(lds + (bufoff) + ldsw + _i * 8192), 16, 0, 0); } while (0)
#define PG8_LDA(dst, b, h) do { _Pragma("unroll") for (int m = 0; m < 4; ++m) _Pragma("unroll") for (int k = 0; k < 2; ++k) dst[m][k] = *(const PG8_LAS bf16x8*)(lds + PG8_SA(b, h) + aoff + m * 2048 + k * 1024); } while (0)
#define PG8_LDB(dst, b, h) do { _Pragma("unroll") for (int n = 0; n < 2; ++n) _Pragma("unroll") for (int k = 0; k < 2; ++k) dst[n][k] = *(const PG8_LAS bf16x8*)(lds + PG8_SB(b, h) + boff + n * 2048 + k * 1024); } while (0)
#define PG8_MMA(ai, bj, At, Bt) do { __builtin_amdgcn_s_setprio(1); _Pragma("unroll") for (int m = 0; m < 4; ++m) _Pragma("unroll") for (int n = 0; n < 2; ++n) _Pragma("unroll") for (int k = 0; k < 2; ++k) \
        acc[ai][bj][m][n] = __builtin_amdgcn_mfma_f32_16x16x32_bf16(Bt[n][k], At[m][k], acc[ai][bj][m][n], 0, 0, 0); __builtin_amdgcn_s_setprio(0); } while (0)
#define PG8_WAIT_V(n) asm volatile("s_waitcnt vmcnt(" #n ")" ::: "memory")
#define PG8_WAIT_L(n) asm volatile("s_waitcnt lgkmcnt(" #n ")" ::: "memory")
#define PG8_BAR __builtin_amdgcn_s_barrier()
#define PG8_SCHED __builtin_amdgcn_sched_barrier(0)
    Unit cur, nxt; int ui = 0;
    if (!S.next(0, cur)) return;
    f32x4 acc[2][2][4][2];
#pragma unroll
    for (int a = 0; a < 2; ++a)
#pragma unroll
        for (int b = 0; b < 2; ++b)
#pragma unroll
            for (int m = 0; m < 4; ++m)
#pragma unroll
                for (int n = 0; n < 2; ++n) acc[a][b][m][n] = (f32x4){0.f, 0.f, 0.f, 0.f};
    bf16x8 At[4][2], B0[2][2], B1[2][2];
    const char* cA = (const char*)g.A + (size_t)cur.pm * tstep; const char* cB = (const char*)g.Bt + (size_t)cur.pn * tstep;
    S.a_ready(cur);
    if constexpr (SP2) {
        PG8_STAGE(PG8_SB(0, 0), cB, voffB); PG8_STAGE(PG8_SB(0, 1), cB + hstep, voffB); PG8_STAGE(PG8_SA(0, 0), cA, voffA); PG8_STAGE(PG8_SA(0, 1), cA + hstep, voffA);
        if (wr == 1) PG8_BAR;
        PG8_WAIT_V(2); PG8_BAR;
        PG8_STAGE(PG8_SB(1, 0), cB + kstep, voffB); PG8_STAGE(PG8_SA(1, 0), cA + kstep, voffA); PG8_STAGE(PG8_SB(1, 1), cB + hstep + kstep, voffB);
        PG8_WAIT_V(6); PG8_BAR;
    } else {
        PG8_STAGE(PG8_SB(0, 0), cB, voffB); PG8_STAGE(PG8_SA(0, 0), cA, voffA); PG8_STAGE(PG8_SB(0, 1), cB + hstep, voffB); PG8_STAGE(PG8_SA(0, 1), cA + hstep, voffA);
        if (wr == 1) PG8_BAR;
        PG8_WAIT_V(4); PG8_BAR;
        PG8_STAGE(PG8_SB(1, 0), cB + kstep, voffB); PG8_STAGE(PG8_SA(1, 0), cA + kstep, voffA); PG8_STAGE(PG8_SB(1, 1), cB + hstep + kstep, voffB);
        PG8_WAIT_V(6); PG8_BAR;
    }
    for (;;) {
        const bool has_next = S.next(ui + 1, nxt);
        const char* nA = has_next ? (const char*)g.A + (size_t)nxt.pm * tstep : cA; const char* nB = has_next ? (const char*)g.Bt + (size_t)nxt.pn * tstep : cB;
        for (int t = 0; t < nt; t += 2) {
            const bool last = (t == nt - 2);
            const char* a1 = cA + (size_t)(t + 1) * kstep;
            const char* a2 = last ? nA : cA + (size_t)(t + 2) * kstep; const char* b2 = last ? nB : cB + (size_t)(t + 2) * kstep;
            const char* a3 = a2 + kstep; const char* b3 = b2 + kstep;
            if (last && has_next) S.a_ready(nxt);
            if constexpr (SP2) {
            PG8_LDB(B0, 0, 0); PG8_LDB(B1, 0, 1); PG8_SCHED; PG8_LDA(At, 0, 0); PG8_STAGE(PG8_SA(1, 1), a1 + hstep, voffA);
            PG8_WAIT_V(8); PG8_WAIT_L(0); PG8_BAR; PG8_MMA(0, 0, At, B0); PG8_MMA(0, 1, At, B1); PG8_BAR; PG8_SCHED;
            PG8_LDA(At, 0, 1); PG8_STAGE(PG8_SB(0, 0), b2, voffB); PG8_STAGE(PG8_SB(0, 1), b2 + hstep, voffB); PG8_STAGE(PG8_SA(0, 0), a2, voffA);
            PG8_WAIT_V(8); PG8_WAIT_L(0); PG8_BAR; PG8_MMA(1, 0, At, B0); PG8_MMA(1, 1, At, B1); PG8_BAR; PG8_SCHED;
            PG8_LDB(B0, 1, 0); PG8_LDB(B1, 1, 1); PG8_SCHED; PG8_LDA(At, 1, 0); PG8_STAGE(PG8_SA(0, 1), a2 + hstep, voffA);
            PG8_WAIT_V(8); PG8_WAIT_L(0); PG8_BAR; PG8_MMA(0, 0, At, B0); PG8_MMA(0, 1, At, B1); PG8_BAR; PG8_SCHED;
            PG8_LDA(At, 1, 1); PG8_STAGE(PG8_SB(1, 0), b3, voffB); PG8_STAGE(PG8_SB(1, 1), b3 + hstep, voffB); PG8_STAGE(PG8_SA(1, 0), a3, voffA);
            PG8_WAIT_V(8); PG8_WAIT_L(0); PG8_BAR; PG8_MMA(1, 0, At, B0); PG8_MMA(1, 1, At, B1); PG8_BAR; PG8_SCHED;
            } else {
            PG8_LDB(B0, 0, 0); PG8_SCHED; PG8_LDA(At, 0, 0); PG8_STAGE(PG8_SA(1, 1), a1 + hstep, voffA);
            PG8_WAIT_L(8); PG8_BAR; PG8_WAIT_L(0); PG8_MMA(0, 0, At, B0); PG8_BAR; PG8_SCHED;
            PG8_LDB(B1, 0, 1); PG8_STAGE(PG8_SB(0, 0), b2, voffB);
            PG8_BAR; PG8_WAIT_L(0); PG8_MMA(0, 1, At, B1); PG8_BAR;
            PG8_LDA(At, 0, 1); PG8_STAGE(PG8_SA(0, 0), a2, voffA);
            PG8_BAR; PG8_WAIT_L(0); PG8_MMA(1, 0, At, B0); PG8_BAR; PG8_SCHED;
            PG8_STAGE(PG8_SB(0, 1), b2 + hstep, voffB);
            PG8_WAIT_V(6); PG8_BAR; PG8_MMA(1, 1, At, B1); PG8_BAR;
            PG8_LDB(B0, 1, 0); PG8_SCHED; PG8_LDA(At, 1, 0); PG8_STAGE(PG8_SA(0, 1), a2 + hstep, voffA);
            PG8_WAIT_L(8); PG8_BAR; PG8_WAIT_L(0); PG8_MMA(0, 0, At, B0); PG8_BAR; PG8_SCHED;
            PG8_LDB(B1, 1, 1); PG8_STAGE(PG8_SB(1, 0), b3, voffB);
            PG8_BAR; PG8_WAIT_L(0); PG8_MMA(0, 1, At, B1); PG8_BAR;
            PG8_LDA(At, 1, 1); PG8_STAGE(PG8_SA(1, 0), a3, voffA);
            PG8_BAR; PG8_WAIT_L(0); PG8_MMA(1, 0, At, B0); PG8_BAR; PG8_SCHED;
            PG8_STAGE(PG8_SB(1, 1), b3 + hstep, voffB);
            PG8_WAIT_V(6); PG8_BAR; PG8_MMA(1, 1, At, B1); PG8_BAR;
            }
        }
        if constexpr (ALIGN_EPI) { if (wr == 0) PG8_BAR; }
        if constexpr (!Epi::AFTER_DRAIN) { E(acc, cur, wr, wc, fr, fq); S.done(cur); }
        if (!has_next) break;
#pragma unroll
        for (int a = 0; a < 2; ++a)
#pragma unroll
            for (int b = 0; b < 2; ++b)
#pragma unroll
                for (int m = 0; m < 4; ++m)
#pragma unroll
                    for (int n = 0; n < 2; ++n) acc[a][b][m][n] = (f32x4){0.f, 0.f, 0.f, 0.f};
        cur = nxt; cA = nA; cB = nB; ++ui;
        if constexpr (ALIGN_EPI) { if (wr == 1) PG8_BAR; }
    }
    PG8_WAIT_V(0);
    if constexpr (!ALIGN_EPI) { if (wr == 0) PG8_BAR; }
    PG8_BAR;
    if constexpr (Epi::AFTER_DRAIN) { E.fused(acc, cur, wr, wc, fr, fq, lds, wid, lane); S.done(cur); }
#undef PG8_SA
#undef PG8_SB
#undef PG8_STAGE
#undef PG8_LDA
#undef PG8_LDB
#undef PG8_MMA
#undef PG8_WAIT_V
#undef PG8_WAIT_L
#undef PG8_BAR
#undef PG8_SCHED
}
}

#ifndef PG8_SP2
#define PG8_SP2 true
#endif
#ifndef PG8_ALIGN
#define PG8_ALIGN true
#endif
namespace cg = cooperative_groups;
#define LAS __attribute__((address_space(3)))
typedef unsigned short bf16;
typedef short bf16x8 __attribute__((ext_vector_type(8)));
typedef float f32x4 __attribute__((ext_vector_type(4)));
typedef float f32x16 __attribute__((ext_vector_type(16)));
typedef unsigned u32x4 __attribute__((ext_vector_type(4)));
typedef unsigned u32x2 __attribute__((ext_vector_type(2)));
using pg8::bflo; using pg8::bfhi; using pg8::sigm; using pg8::cvt_pk_bf16;

constexpr int T_ALL = 32768, TH = 16384, DM = 1024, SEQ = 4096, HP = pg8::HPITCH, DFF = 2816, INC = 7688;
constexpr int C_GU = 0, C_GV = 512, C_RQ = 1024, C_RF = 1536, C_RI = 2048, C_RG = 2560, C_AQ = 3072, C_AK = 3584, C_AV = 4096, C_GATE = 4608, C_AF = 7680;
constexpr float LOG2E = 1.4426950408889634f;
constexpr size_t MiB = 1u << 20;
constexpr size_t WS_CTL = 0, WS_W = 1 * MiB, W_LAYER = 37 * MiB;
constexpr size_t WIN_OFF = 0, WP_OFF = 16252928, WO_OFF = WP_OFF + 3145728, WGU_OFF = WO_OFF + 2097152, WD_OFF = WGU_OFF + 11534336;
static_assert(WD_OFF + 5767168 == W_LAYER, "weight map");
constexpr size_t WS_XB = 75 * MiB, WS_H = 139 * MiB, WS_Y = 387 * MiB, WS_MB = 435 * MiB, WS_U = 467 * MiB, WS_DEC = 499 * MiB, WS_GF = WS_DEC + 512 * 1024, WS_END = 500 * MiB;
constexpr int LDS_BYTES = 147456;
#define RLX_AGENT __ATOMIC_RELAXED, __HIP_MEMORY_SCOPE_AGENT
constexpr int NPHASE = 33;

struct Args {
    const float *x, *w_in, *gln_g, *gln_b, *g_ws, *g_bs, *lb_logits, *r_norm_w, *fox_fb, *w_pg, *w_pr, *w_pa, *w_o, *ln1_g, *ln1_b, *w_gate, *w_up, *w_down, *ln2_g, *ln2_b;
    float* out; unsigned char* ws; int lo, hi;
};

__device__ __forceinline__ unsigned short f2bf(float f) { unsigned u = __float_as_uint(f); return (unsigned short)((u + 0x7fffu + ((u >> 16) & 1u)) >> 16); }
__device__ __forceinline__ float bf2f(unsigned short b) { return __uint_as_float((unsigned)b << 16); }
__device__ __forceinline__ float wave_sum(float v) {
#pragma unroll
    for (int o = 1; o < 64; o <<= 1) v += __shfl_xor(v, o);
    return v;
}
__device__ __forceinline__ f32x4 mfma16(bf16x8 a, bf16x8 b, f32x4 c) { return __builtin_amdgcn_mfma_f32_16x16x32_bf16(a, b, c, 0, 0, 0); }
__device__ __forceinline__ f32x16 mfma32(bf16x8 a, bf16x8 b, f32x16 c) { return __builtin_amdgcn_mfma_f32_32x32x16_bf16(a, b, c, 0, 0, 0); }

__device__ __forceinline__ int rowmap(int mode, int n) {
    if (mode == 1) return n < 4608 ? n : (n < 4616 ? 7680 + (n - 4608) : 4608 + (n - 4616));
    if (mode == 2) return (n >> 7) * 256 + (n & 127);
    if (mode == 3) return (n >> 7) * 256 + 128 + (n & 127);
    return n;
}
__device__ __forceinline__ void transpose_item(const float* W, int K, int N, bf16* WT, int mode, int row_off, LAS float* scr, int item, int lane) {
    const int nblk = (N + 31) / 32, kb = item / nblk, nb = item % nblk, k0 = 64 * kb, n0 = 32 * nb;
    const int nn = n0 + (lane & 31);
#pragma unroll 8
    for (int i = 0; i < 32; ++i) { const int kk = 2 * i + (lane >> 5); scr[kk * 33 + (lane & 31)] = nn < N ? W[(size_t)(k0 + kk) * N + nn] : 0.f; }
    asm volatile("s_waitcnt lgkmcnt(0)" ::: "memory");
    const int c = lane & 7;
#pragma unroll
    for (int j = 0; j < 4; ++j) { const int n = (lane >> 3) + 8 * j; const LAS float* s = scr + (8 * c) * 33 + n;
        u32x4 o; o.x = cvt_pk_bf16(s[0 * 33], s[1 * 33]); o.y = cvt_pk_bf16(s[2 * 33], s[3 * 33]); o.z = cvt_pk_bf16(s[4 * 33], s[5 * 33]); o.w = cvt_pk_bf16(s[6 * 33], s[7 * 33]);
        if (n0 + n < N) *(u32x4*)(WT + (size_t)(row_off + rowmap(mode, n0 + n)) * K + k0 + 8 * c) = o; }
    asm volatile("s_waitcnt lgkmcnt(0)" ::: "memory");
}
__device__ __forceinline__ void prep_phase(const Args& a, LAS unsigned char* lds) {
    const int tid = otid(), lane = tid & 63, wave = tid >> 6;
    const int gw = obid() * 8 + wave, NGW = gridDim.x * 8;
    LAS float* scr = (LAS float*)(lds + wave * 16384);
    constexpr int I_IN = 16 * 241, I_P = 8 * 32, I_O = 16 * 32, I_G = 16 * 88, I_D = 44 * 32;
    constexpr int PER_L = I_IN + 3 * I_P + I_O + 2 * I_G + I_D;
    for (int it = gw; it < 2 * PER_L; it += NGW) {
        const int l = it / PER_L; int r = it % PER_L;
        unsigned char* wl = a.ws + WS_W + (size_t)l * W_LAYER;
        if (r < I_IN) { transpose_item(a.w_in + (size_t)l * 1024 * INC, 1024, INC, (bf16*)(wl + WIN_OFF), 1, 0, scr, r, lane); continue; } r -= I_IN;
        if (r < I_P) { transpose_item(a.w_pg + (size_t)l * 512 * 1024, 512, 1024, (bf16*)(wl + WP_OFF), 0, 0, scr, r, lane); continue; } r -= I_P;
        if (r < I_P) { transpose_item(a.w_pr + (size_t)l * 512 * 1024, 512, 1024, (bf16*)(wl + WP_OFF), 0, 1024, scr, r, lane); continue; } r -= I_P;
        if (r < I_P) { transpose_item(a.w_pa + (size_t)l * 512 * 1024, 512, 1024, (bf16*)(wl + WP_OFF), 0, 2048, scr, r, lane); continue; } r -= I_P;
        if (r < I_O) { transpose_item(a.w_o + (size_t)l * 1024 * 1024, 1024, 1024, (bf16*)(wl + WO_OFF), 0, 0, scr, r, lane); continue; } r -= I_O;
        if (r < I_G) { transpose_item(a.w_gate + (size_t)l * 1024 * DFF, 1024, DFF, (bf16*)(wl + WGU_OFF), 2, 0, scr, r, lane); continue; } r -= I_G;
        if (r < I_G) { transpose_item(a.w_up + (size_t)l * 1024 * DFF, 1024, DFF, (bf16*)(wl + WGU_OFF), 3, 0, scr, r, lane); continue; } r -= I_G;
        transpose_item(a.w_down + (size_t)l * DFF * 1024, DFF, 1024, (bf16*)(wl + WD_OFF), 0, 0, scr, r, lane);
    }
    const int gt = obid() * 512 + tid, NGT = gridDim.x * 512;
    for (int i = gt; i < 2 * 31744; i += NGT) { const int l = i / 31744, j = i % 31744; ((u32x4*)(a.ws + WS_W + (size_t)l * W_LAYER + WIN_OFF + (size_t)7688 * 1024 * 2))[j] = (u32x4){0u, 0u, 0u, 0u}; }
    bf16* XB = (bf16*)(a.ws + WS_XB);
    for (int i = gt; i < T_ALL * DM / 4; i += NGT) { const f32x4 v = ((const f32x4*)a.x)[i]; u32x2 o; o.x = cvt_pk_bf16(v[0], v[1]); o.y = cvt_pk_bf16(v[2], v[3]); ((u32x2*)XB)[i] = o; }
}
__device__ __forceinline__ void ln_phase(float* X, const float* g, const float* b, bf16* XB) {
    const int tid = otid(), lane = tid & 63, wave = tid >> 6;
    const int gw = obid() * 8 + wave, NGW = gridDim.x * 8;
    for (int row = gw; row < T_ALL; row += NGW) {
        f32x4* xr = (f32x4*)(X + (size_t)row * DM) + lane;
        f32x4 v[4]; float s = 0.f;
#pragma unroll
        for (int j = 0; j < 4; ++j) { v[j] = xr[64 * j]; s += (v[j][0] + v[j][1]) + (v[j][2] + v[j][3]); }
        const float mean = wave_sum(s) * (1.f / DM); float s2 = 0.f;
#pragma unroll
        for (int j = 0; j < 4; ++j) { v[j] = v[j] - mean; s2 += (v[j][0] * v[j][0] + v[j][1] * v[j][1]) + (v[j][2] * v[j][2] + v[j][3] * v[j][3]); }
        const float rstd = 1.f / sqrtf(wave_sum(s2) * (1.f / DM) + 1e-5f);
        u32x2* o8 = (u32x2*)(XB + (size_t)row * DM) + lane;
#pragma unroll
        for (int j = 0; j < 4; ++j) { const f32x4 gg = ((const f32x4*)g)[lane + 64 * j], bb = ((const f32x4*)b)[lane + 64 * j]; const f32x4 o = v[j] * rstd * gg + bb;
            xr[64 * j] = o; u32x2 w; w.x = cvt_pk_bf16(o[0], o[1]); w.y = cvt_pk_bf16(o[2], o[3]); o8[64 * j] = w; }
    }
}
__device__ __forceinline__ void gmlp_phase(const Args& a, int l, LAS unsigned char* lds) {
    const int tid = otid(), lane = tid & 63, w = tid >> 6, fr = lane & 15, fq = lane >> 4;
    const bf16* H = (const bf16*)(a.ws + WS_H);
    bf16* YG = (bf16*)(a.ws + WS_Y);
    LAS bf16* Wl = (LAS bf16*)lds;
    LAS bf16* vT = (LAS bf16*)(lds + 34816);
    const float* lng = a.gln_g + l * 512; const float* lnb = a.gln_b + l * 512;
    const float* wsp = a.g_ws + (size_t)l * 4 * 128 * 128; const float* bsp = a.g_bs + l * 4 * 128;
    for (int u = obid(); u < 512; u += gridDim.x) {
        const int g = u & 3, n = (u >> 2) & 31, bl = u >> 7;
        const int r0 = bl * SEQ + n * 128;
        for (int i = 0; i < 16; ++i) {
            const int row = w * 16 + i;
            const u32x4 raw = *(const u32x4*)(H + (size_t)(r0 + row) * HP + C_GV + lane * 8);
            float f[8] = {bflo(raw.x), bfhi(raw.x), bflo(raw.y), bfhi(raw.y), bflo(raw.z), bfhi(raw.z), bflo(raw.w), bfhi(raw.w)};
            float s = 0.f;
#pragma unroll
            for (int e = 0; e < 8; ++e) s += f[e];
            const float mean = wave_sum(s) * (1.f / 512.f); float s2 = 0.f;
#pragma unroll
            for (int e = 0; e < 8; ++e) { f[e] -= mean; s2 += f[e] * f[e]; }
            const float rstd = 1.f / sqrtf(wave_sum(s2) * (1.f / 512.f) + 1e-5f);
            if ((lane >> 4) == g) { const int c0 = (lane & 15) * 8;
#pragma unroll
                for (int e = 0; e < 8; ++e) vT[(c0 + e) * 136 + row] = f2bf(f[e] * rstd * lng[g * 128 + c0 + e] + lnb[g * 128 + c0 + e]); }
        }
        { const int t = tid >> 2, seg = (tid & 3) * 32; const float* wp = wsp + (size_t)(g * 128 + t) * 128 + seg;
#pragma unroll
            for (int j = 0; j < 4; ++j) { const f32x4 x0 = *(const f32x4*)(wp + 8 * j), x1 = *(const f32x4*)(wp + 8 * j + 4); const int s0 = seg + 8 * j;
                u32x4 o; o.x = cvt_pk_bf16(s0 + 0 <= t ? x0[0] : 0.f, s0 + 1 <= t ? x0[1] : 0.f); o.y = cvt_pk_bf16(s0 + 2 <= t ? x0[2] : 0.f, s0 + 3 <= t ? x0[3] : 0.f);
                o.z = cvt_pk_bf16(s0 + 4 <= t ? x1[0] : 0.f, s0 + 5 <= t ? x1[1] : 0.f); o.w = cvt_pk_bf16(s0 + 6 <= t ? x1[2] : 0.f, s0 + 7 <= t ? x1[3] : 0.f);
                *(LAS u32x4*)(Wl + t * 136 + s0) = o; } }
        __syncthreads();
        f32x4 acc[8];
#pragma unroll
        for (int cb = 0; cb < 8; ++cb) acc[cb] = (f32x4){0.f, 0.f, 0.f, 0.f};
        const int nsb = (w >> 1) + 1;
        for (int sb = 0; sb < nsb; ++sb) {
            const bf16x8 tf = *(const LAS bf16x8*)(Wl + (16 * w + fr) * 136 + 32 * sb + 8 * fq);
#pragma unroll
            for (int cb = 0; cb < 8; ++cb) { const bf16x8 cf = *(const LAS bf16x8*)(vT + (16 * cb + fr) * 136 + 32 * sb + 8 * fq); acc[cb] = mfma16(cf, tf, acc[cb]); }
        }
        { const int t = 16 * w + fr; const float bsv = bsp[g * 128 + t]; const size_t hrow = (size_t)(r0 + t);
#pragma unroll
            for (int cb = 0; cb < 8; ++cb) { const int c = g * 128 + 16 * cb + 4 * fq; const u32x2 ur = *(const u32x2*)(H + hrow * HP + C_GU + c);
                u32x2 o; o.x = cvt_pk_bf16(bflo(ur.x) * (acc[cb][0] + bsv), bfhi(ur.x) * (acc[cb][1] + bsv)); o.y = cvt_pk_bf16(bflo(ur.y) * (acc[cb][2] + bsv), bfhi(ur.y) * (acc[cb][3] + bsv));
                *(u32x2*)(YG + hrow * 512 + c) = o; } }
        __syncthreads();
    }
}
__device__ __forceinline__ void fprep_phase(const Args& a, int l) {
    const int tid = otid(), lane = tid & 63, w = tid >> 6;
    const bf16* H = (const bf16*)(a.ws + WS_H);
    float* GF = (float*)(a.ws + WS_GF);
    for (int u = (int)gridDim.x - 1 - obid(); u < 4; u += gridDim.x) {
        const float fb = a.fox_fb[l * 8 + w];
        const bf16* p = H + (size_t)(u * SEQ + lane * 64) * HP + C_AF + w;
        float ls[64]; float run = 0.f;
#pragma unroll
        for (int i = 0; i < 64; ++i) { const float z = bf2f(p[(size_t)i * HP]) + fb; ls[i] = fminf(z, 0.f) - log1pf(__expf(-fabsf(z))); run += ls[i]; }
        float incl = run;
#pragma unroll
        for (int o = 1; o < 64; o <<= 1) { const float t = __shfl_up(incl, o); if (lane >= o) incl += t; }
        float acc = incl - run;
        float* gp = GF + (size_t)(u * 8 + w) * SEQ + lane * 64;
#pragma unroll
        for (int i = 0; i < 64; ++i) { acc += ls[i]; gp[i] = acc * LOG2E; }
    }
}
__device__ __forceinline__ void hgrn_gates(const bf16* Hz, float lb, int col, int part, LAS float* PS, float (&kk)[16], float (&cum)[16], float& last, float& rmid) {
    float run = 0.f; const float lbf = fmaxf(lb, 1e-30f), omlb = 1.f - lb;
#pragma unroll
    for (int i = 0; i < 16; ++i) { const float z = bf2f(Hz[(size_t)(16 * part + i) * HP + col]); const float sg = 1.f / (1.f + __expf(-z)), sgn = 1.f / (1.f + __expf(z));
        const float lf = logf(lbf + omlb * sg); kk[i] = omlb * sgn; run += lf; cum[i] = run; }
    PS[part * 128 + col] = run; __syncthreads();
    const float p0 = PS[col], p1 = PS[128 + col], p2 = PS[256 + col], p3 = PS[384 + col];
    const float prefix = (part > 0 ? p0 : 0.f) + (part > 1 ? p1 : 0.f) + (part > 2 ? p2 : 0.f);
    last = (p0 + p1) + (p2 + p3); rmid = p0 + p1;
#pragma unroll
    for (int i = 0; i < 16; ++i) cum[i] += prefix;
}
__device__ __forceinline__ float hgrn_lb(const Args& a, int l, int j) { if (l == 0) return 0.f; return 1.f / (1.f + __expf(a.lb_logits[j] - a.lb_logits[512 + j])); }
__device__ __forceinline__ void hgrn1_phase(const Args& a, int l, LAS unsigned char* lds) {
    const int tid = otid(), lane = tid & 63, w = tid >> 6, fr = lane & 15, fq = lane >> 4, col = tid & 127, part = tid >> 7;
    const bf16* H = (const bf16*)(a.ws + WS_H);
    bf16* U = (bf16*)(a.ws + WS_U); float* DEC = (float*)(a.ws + WS_DEC);
    LAS bf16* KT = (LAS bf16*)lds;
    LAS bf16* VT = (LAS bf16*)(lds + 18432);
    LAS float* PS = (LAS float*)(lds + 36864);
    for (int u = obid(); u < 1024; u += gridDim.x) {
        const int c = u & 63, h = (u >> 6) & 3, bl = u >> 8; const int s0 = bl * SEQ + c * 64;
        const float lb = hgrn_lb(a, l, h * 128 + col);
        float kk[16], cum[16], last, rmid;
        hgrn_gates(H + (size_t)s0 * HP + C_RF + h * 128, lb, col, part, PS, kk, cum, last, rmid);
#pragma unroll
        for (int i = 0; i < 16; ++i) { const int s = 16 * part + i; KT[col * 72 + s] = f2bf(kk[i] * __expf(last - cum[i])); VT[col * 72 + s] = H[(size_t)(s0 + s) * HP + C_RI + h * 128 + col]; }
        const size_t ci = (size_t)((bl * 4 + h) * 64 + c);
        if (part == 0) DEC[ci * 128 + col] = __expf(last);
        __syncthreads();
        bf16x8 vf[2];
#pragma unroll
        for (int ks = 0; ks < 2; ++ks) vf[ks] = *(const LAS bf16x8*)(VT + (16 * w + fr) * 72 + 32 * ks + 8 * fq);
#pragma unroll
        for (int kb = 0; kb < 8; ++kb) { f32x4 acc = (f32x4){0.f, 0.f, 0.f, 0.f};
#pragma unroll
            for (int ks = 0; ks < 2; ++ks) { const bf16x8 kf = *(const LAS bf16x8*)(KT + (16 * kb + fr) * 72 + 32 * ks + 8 * fq); acc = mfma16(kf, vf[ks], acc); }
            u32x2 o; o.x = cvt_pk_bf16(acc[0], acc[1]); o.y = cvt_pk_bf16(acc[2], acc[3]);
            *(u32x2*)(U + (ci * 128 + 16 * w + fr) * 128 + 16 * kb + 4 * fq) = o; }
        __syncthreads();
    }
}
__device__ __forceinline__ void hgrn2_phase(const Args& a) {
    unsigned* U = (unsigned*)(a.ws + WS_U); const float* DEC = (const float*)(a.ws + WS_DEC);
    for (int p = obid() * 512 + otid(); p < 131072; p += gridDim.x * 512) {
        const int bh = p >> 13, e2 = p & 8191, k = (e2 * 2) & 127;
        unsigned* up = U + (size_t)bh * 64 * 8192 + e2; const float* dp = DEC + (size_t)bh * 64 * 128 + k;
        float s0 = 0.f, s1 = 0.f;
#pragma unroll 8
        for (int c = 0; c < 64; ++c) { const unsigned uv = up[(size_t)c * 8192]; const float d0 = dp[c * 128], d1 = dp[c * 128 + 1]; up[(size_t)c * 8192] = cvt_pk_bf16(s0, s1); s0 = d0 * s0 + bflo(uv); s1 = d1 * s1 + bfhi(uv); }
    }
}
__device__ __forceinline__ void hgrn3_phase(const Args& a, int l, LAS unsigned char* lds) {
    const int tid = otid(), lane = tid & 63, w = tid >> 6, fr = lane & 15, fq = lane >> 4, col = tid & 127, part = tid >> 7;
    const bf16* H = (const bf16*)(a.ws + WS_H);
    const bf16* U = (const bf16*)(a.ws + WS_U);
    bf16* YR = (bf16*)(a.ws + WS_Y) + (size_t)TH * 512;
    LAS bf16* QI = (LAS bf16*)lds;
    LAS bf16* QH = (LAS bf16*)(lds + 17408);
    LAS bf16* KH = (LAS bf16*)(lds + 34816);
    LAS bf16* VT = (LAS bf16*)(lds + 52224);
    LAS bf16* SC = (LAS bf16*)(lds + 70656);
    LAS float* PS = (LAS float*)(lds + 79872);
    LAS float* RS = (LAS float*)(lds + 81920);
    const float* nw = a.r_norm_w + l * 128;
    for (int u = obid(); u < 1024; u += gridDim.x) {
        const int c = u & 63, h = (u >> 6) & 3, bl = u >> 8; const int s0 = bl * SEQ + c * 64;
        const float lb = hgrn_lb(a, l, h * 128 + col);
        float kk[16], cum[16], last, rmid;
        hgrn_gates(H + (size_t)s0 * HP + C_RF + h * 128, lb, col, part, PS, kk, cum, last, rmid);
#pragma unroll
        for (int i = 0; i < 16; ++i) { const int s = 16 * part + i; const size_t hr = (size_t)(s0 + s) * HP + h * 128 + col;
            const float q = bf2f(H[hr + C_RQ]);
            QI[s * 136 + col] = f2bf(q * __expf(cum[i])); QH[s * 136 + col] = f2bf(q * __expf(cum[i] - rmid)); KH[s * 136 + col] = f2bf(kk[i] * __expf(rmid - cum[i]));
            VT[col * 72 + s] = H[hr + C_RI]; }
        __syncthreads();
        const int tb = w & 3, hw = w >> 2;
#pragma unroll
        for (int j = 0; j < 2; ++j) { const int sb = 2 * hw + j; f32x4 acc = (f32x4){0.f, 0.f, 0.f, 0.f};
            if (sb <= tb) {
#pragma unroll
                for (int ks = 0; ks < 4; ++ks) { const bf16x8 kf = *(const LAS bf16x8*)(KH + (16 * sb + fr) * 136 + 32 * ks + 8 * fq), qf = *(const LAS bf16x8*)(QH + (16 * tb + fr) * 136 + 32 * ks + 8 * fq); acc = mfma16(kf, qf, acc); }
            }
            const int t = 16 * tb + fr, sbase = 16 * sb + 4 * fq;
            u32x2 o; o.x = cvt_pk_bf16(sbase + 0 <= t ? acc[0] : 0.f, sbase + 1 <= t ? acc[1] : 0.f); o.y = cvt_pk_bf16(sbase + 2 <= t ? acc[2] : 0.f, sbase + 3 <= t ? acc[3] : 0.f);
            *(LAS u32x2*)(SC + t * 72 + sbase) = o; }
        __syncthreads();
        const size_t ci = (size_t)((bl * 4 + h) * 64 + c);
        f32x4 o4[4]; float ssq = 0.f;
        { bf16x8 sf[2], qf[4];
#pragma unroll
            for (int ks = 0; ks < 2; ++ks) sf[ks] = *(const LAS bf16x8*)(SC + (16 * tb + fr) * 72 + 32 * ks + 8 * fq);
#pragma unroll
            for (int ks = 0; ks < 4; ++ks) qf[ks] = *(const LAS bf16x8*)(QI + (16 * tb + fr) * 136 + 32 * ks + 8 * fq);
#pragma unroll
            for (int nb = 0; nb < 4; ++nb) { const int vb = hw * 64 + nb * 16; f32x4 acc = (f32x4){0.f, 0.f, 0.f, 0.f};
#pragma unroll
                for (int ks = 0; ks < 2; ++ks) { const bf16x8 vf = *(const LAS bf16x8*)(VT + (vb + fr) * 72 + 32 * ks + 8 * fq); acc = mfma16(vf, sf[ks], acc); }
#pragma unroll
                for (int ks = 0; ks < 4; ++ks) { const bf16x8 uf = *(const bf16x8*)(U + (ci * 128 + vb + fr) * 128 + 32 * ks + 8 * fq); acc = mfma16(uf, qf[ks], acc); }
                o4[nb] = acc; ssq += (acc[0] * acc[0] + acc[1] * acc[1]) + (acc[2] * acc[2] + acc[3] * acc[3]); } }
        ssq += __shfl_xor(ssq, 16); ssq += __shfl_xor(ssq, 32);
        if (fq == 0) RS[hw * 64 + 16 * tb + fr] = ssq;
        __syncthreads();
        { const int t = 16 * tb + fr; const float rstd = 1.f / sqrtf((RS[t] + RS[64 + t]) * (1.f / 128.f) + 1e-6f); const size_t hrow = (size_t)(s0 + t);
#pragma unroll
            for (int nb = 0; nb < 4; ++nb) { const int v = hw * 64 + nb * 16 + 4 * fq; const u32x2 gr = *(const u32x2*)(H + hrow * HP + C_RG + h * 128 + v); const f32x4 nv = *(const f32x4*)(nw + v);
                const float g0 = bflo(gr.x), g1 = bfhi(gr.x), g2 = bflo(gr.y), g3 = bfhi(gr.y);
                u32x2 o; o.x = cvt_pk_bf16(o4[nb][0] * rstd * nv[0] * g0 * sigm(g0), o4[nb][1] * rstd * nv[1] * g1 * sigm(g1)); o.y = cvt_pk_bf16(o4[nb][2] * rstd * nv[2] * g2 * sigm(g2), o4[nb][3] * rstd * nv[3] * g3 * sigm(g3));
                *(u32x2*)(YR + hrow * 512 + h * 128 + v) = o; } }
        __syncthreads();
    }
}
__device__ __forceinline__ int crow(int r, int hi) { return (r & 3) + 8 * (r >> 2) + 4 * hi; }
__device__ __forceinline__ void attn_unit(const Args& a, int bl, int h, int qb, LAS unsigned char* lds) {
    const int tid = otid(), lane = tid & 63, w = tid >> 6, r32 = lane & 31, hi = lane >> 5;
    const bf16* H = (const bf16*)(a.ws + WS_H);
    const float* G = (const float*)(a.ws + WS_GF) + (size_t)(bl * 8 + h) * SEQ;
    bf16* YA = (bf16*)(a.ws + WS_Y) + (size_t)2 * TH * 512;
    LAS bf16* Ks = (LAS bf16*)lds;
    LAS bf16* VT = (LAS bf16*)(lds + 9216);
    LAS float* Gs = (LAS float*)(lds + 18432);
    const size_t rowbase = (size_t)bl * SEQ;
    const int q0 = qb * 256 + w * 32;
    bf16x8 qr[4];
#pragma unroll
    for (int d0 = 0; d0 < 4; ++d0) qr[d0] = *(const bf16x8*)(H + (rowbase + q0 + r32) * HP + C_AQ + h * 64 + d0 * 16 + hi * 8);
    const float Gq = G[q0 + r32];
    float m = -1e30f, lsum = 0.f; f32x16 oT[2];
#pragma unroll
    for (int r = 0; r < 16; ++r) { oT[0][r] = 0.f; oT[1][r] = 0.f; }
    const int NT = 4 * qb + 4;
    const int kvr = tid >> 3, ch = tid & 7;
    const int kvp = (kvr & ~12) | ((kvr & 4) << 1) | ((kvr & 8) >> 1);
    const bf16* kp = H + (rowbase + kvr) * HP + C_AK + h * 64 + ch * 8;
    const bf16* vp = H + (rowbase + kvr) * HP + C_AV + h * 64 + ch * 8;
    u32x4 kreg = *(const u32x4*)kp, vreg = *(const u32x4*)vp; float greg = (tid < 64) ? G[tid] : 0.f;
    for (int t = 0; t < NT; ++t) {
        __syncthreads();
        *(LAS u32x4*)(Ks + kvr * 72 + ch * 8) = kreg;
        { LAS bf16* vd = VT + (ch * 8) * 72 + kvp;
          vd[0 * 72] = (bf16)(vreg.x & 0xffffu); vd[1 * 72] = (bf16)(vreg.x >> 16); vd[2 * 72] = (bf16)(vreg.y & 0xffffu); vd[3 * 72] = (bf16)(vreg.y >> 16);
          vd[4 * 72] = (bf16)(vreg.z & 0xffffu); vd[5 * 72] = (bf16)(vreg.z >> 16); vd[6 * 72] = (bf16)(vreg.w & 0xffffu); vd[7 * 72] = (bf16)(vreg.w >> 16); }
        if (tid < 64) Gs[tid] = greg;
        __syncthreads();
        if (t + 1 < NT) { kreg = *(const u32x4*)(kp + (size_t)(t + 1) * 64 * HP); vreg = *(const u32x4*)(vp + (size_t)(t + 1) * 64 * HP); if (tid < 64) greg = G[(t + 1) * 64 + tid]; }
        const int kv0 = 64 * t;
        if (kv0 > q0 + 31) continue;
        f32x16 p0, p1;
#pragma unroll
        for (int r = 0; r < 16; ++r) { p0[r] = 0.f; p1[r] = 0.f; }
#pragma unroll
        for (int d0 = 0; d0 < 4; ++d0) { const bf16x8 k0 = *(const LAS bf16x8*)(Ks + r32 * 72 + d0 * 16 + hi * 8), k1 = *(const LAS bf16x8*)(Ks + (32 + r32) * 72 + d0 * 16 + hi * 8);
            p0 = mfma32(k0, qr[d0], p0); p1 = mfma32(k1, qr[d0], p1); }
#pragma unroll
        for (int rg = 0; rg < 4; ++rg) { const f32x4 g0 = *(const LAS f32x4*)(Gs + 8 * rg + 4 * hi), g1 = *(const LAS f32x4*)(Gs + 32 + 8 * rg + 4 * hi);
#pragma unroll
            for (int e = 0; e < 4; ++e) { p0[4 * rg + e] += Gq - g0[e]; p1[4 * rg + e] += Gq - g1[e]; } }
        if (kv0 + 63 > q0) { const int q = q0 + r32;
#pragma unroll
            for (int r = 0; r < 16; ++r) { const int kv = kv0 + crow(r, hi); if (kv > q) p0[r] = -1e30f; if (kv + 32 > q) p1[r] = -1e30f; } }
        float mx = fmaxf(p0[0], p1[0]);
#pragma unroll
        for (int r = 1; r < 16; ++r) mx = fmaxf(mx, fmaxf(p0[r], p1[r]));
        mx = fmaxf(mx, __shfl_xor(mx, 32));
        const float mnew = fmaxf(m, mx), alpha = __builtin_amdgcn_exp2f(m - mnew); m = mnew;
        float rs = 0.f;
#pragma unroll
        for (int r = 0; r < 16; ++r) { p0[r] = __builtin_amdgcn_exp2f(p0[r] - mnew); p1[r] = __builtin_amdgcn_exp2f(p1[r] - mnew); rs += p0[r] + p1[r]; }
        lsum = lsum * alpha + rs;
#pragma unroll
        for (int r = 0; r < 16; ++r) { oT[0][r] *= alpha; oT[1][r] *= alpha; }
        u32x4 pw[4];
#pragma unroll
        for (int j = 0; j < 2; ++j) { pw[j] = (u32x4){cvt_pk_bf16(p0[8 * j + 0], p0[8 * j + 1]), cvt_pk_bf16(p0[8 * j + 2], p0[8 * j + 3]), cvt_pk_bf16(p0[8 * j + 4], p0[8 * j + 5]), cvt_pk_bf16(p0[8 * j + 6], p0[8 * j + 7])};
            pw[2 + j] = (u32x4){cvt_pk_bf16(p1[8 * j + 0], p1[8 * j + 1]), cvt_pk_bf16(p1[8 * j + 2], p1[8 * j + 3]), cvt_pk_bf16(p1[8 * j + 4], p1[8 * j + 5]), cvt_pk_bf16(p1[8 * j + 6], p1[8 * j + 7])}; }
#pragma unroll
        for (int dh = 0; dh < 2; ++dh)
#pragma unroll
            for (int j = 0; j < 4; ++j) { const bf16x8 vf = *(const LAS bf16x8*)(VT + (dh * 32 + r32) * 72 + 16 * j + 8 * hi); oT[dh] = mfma32(vf, __builtin_bit_cast(bf16x8, pw[j]), oT[dh]); }
    }
    lsum += __shfl_xor(lsum, 32);
    const float inv = 1.f / lsum;
    bf16* op = YA + (rowbase + q0 + r32) * 512 + h * 64;
#pragma unroll
    for (int dh = 0; dh < 2; ++dh)
#pragma unroll
        for (int rg = 0; rg < 4; ++rg) { u32x2 o; o.x = cvt_pk_bf16(oT[dh][4 * rg + 0] * inv, oT[dh][4 * rg + 1] * inv); o.y = cvt_pk_bf16(oT[dh][4 * rg + 2] * inv, oT[dh][4 * rg + 3] * inv);
            *(u32x2*)(op + dh * 32 + 8 * rg + 4 * hi) = o; }
}
__device__ __forceinline__ void attn_phase(const Args& a, LAS unsigned char* lds) {
    const int G = gridDim.x, bx = obid();
    const int vcu0 = (G % 8 == 0) ? (bx % 8) * (G / 8) + bx / 8 : bx;
    for (int v = vcu0; v < 256; v += G) { const int bh = v >> 3, s = v & 7;
        attn_unit(a, bh >> 3, bh & 7, 15 - s, lds); attn_unit(a, bh >> 3, bh & 7, s, lds); }
}
#define XB_TMO      128
#define XB_XCNT(j)  (256  + 64 * (j))
#define XB_XSUB(j)  (1280 + 64 * (j))
#define XB_XGEN(j)  (2304 + 64 * (j))
#define XB_TOP      3328
#define XB_TOPGEN   3392
#define XCD_BAR_WORDS 3456
#define XB_SPIN_CAP (1u << 18)

__device__ __forceinline__ unsigned xb_ld(unsigned* p)              { return __hip_atomic_load(p, __ATOMIC_RELAXED, __HIP_MEMORY_SCOPE_AGENT); }
__device__ __forceinline__ unsigned xb_add(unsigned* p, unsigned v) { return __hip_atomic_fetch_add(p, v, __ATOMIC_RELAXED, __HIP_MEMORY_SCOPE_AGENT); }
__device__ __forceinline__ unsigned xb_xcc_id() { return (unsigned)__builtin_amdgcn_s_getreg((3 << 11) | 20) & 0xFu; }
#define XB_SPIN(cond, bar) do { unsigned _sp = 0; while (cond) { __builtin_amdgcn_s_sleep(1); \
    if ((++_sp & 255u) == 0u) { if (xb_ld(&(bar)[XB_TMO])) break; if (_sp > XB_SPIN_CAP) { atomicAdd(&(bar)[XB_TMO], 1u); break; } } } } while (0)

struct XcdBarrier {
    unsigned* bar; unsigned x;
    volatile LAS unsigned* st;
};

__device__ __forceinline__ XcdBarrier xcd_barrier_post(unsigned* bar, volatile LAS unsigned* st) {
    XcdBarrier b; b.bar = bar; b.x = xb_xcc_id(); b.st = st;
    if (threadIdx.x == 0) (void)xb_add(&bar[XB_XCNT(b.x)], 1u);
    return b;
}
__device__ __forceinline__ void xcd_barrier_complete(unsigned* bar, unsigned x, unsigned& nloc, unsigned& nx) {
    const unsigned G = gridDim.x * gridDim.y * gridDim.z;
    unsigned sum, cnt, mine, sp = 0u;
    for (;;) {
        sum = 0u; cnt = 0u; mine = 0u;
#pragma unroll
        for (unsigned j = 0; j < 16; ++j) { const unsigned c = xb_ld(&bar[XB_XCNT(j)]); sum += c; cnt += (c > 0u) ? 1u : 0u; mine = (j == x) ? c : mine; }
        if (sum == G) break;
        __builtin_amdgcn_s_sleep(1);
        if ((++sp & 255u) == 0u) { if (xb_ld(&bar[XB_TMO])) break; if (sp > XB_SPIN_CAP) { atomicAdd(&bar[XB_TMO], 1u); break; } }
    }
    nloc = mine > 0u ? mine : 1u; nx = cnt > 0u ? cnt : 1u;
}

__device__ __forceinline__ void xcd_barrier(const XcdBarrier& b) {
    asm volatile("s_waitcnt vmcnt(0)" ::: "memory");
    __syncthreads();
    if (threadIdx.x == 0) {
        unsigned* bar = b.bar;
        __builtin_amdgcn_s_waitcnt(0);
        unsigned nloc = b.st[0], nx = b.st[1];
        if (nloc == 0u) { xcd_barrier_complete(bar, b.x, nloc, nx); b.st[0] = nloc; b.st[1] = nx; }
        const unsigned old = xb_add(&bar[XB_XSUB(b.x)], 1u);
        const unsigned gen = old / nloc;
        if (old + 1u == (gen + 1u) * nloc) {
            __builtin_amdgcn_fence(__ATOMIC_RELEASE, "agent");
            asm volatile("s_waitcnt vmcnt(0)" ::: "memory");
            const unsigned og = xb_add(&bar[XB_TOP], 1u);
            const unsigned tg = og / nx;
            if (og + 1u == (tg + 1u) * nx) xb_add(&bar[XB_TOPGEN], 1u);
            else XB_SPIN(xb_ld(&bar[XB_TOPGEN]) == tg, bar);
            __builtin_amdgcn_fence(__ATOMIC_ACQUIRE, "agent");
            xb_add(&bar[XB_XGEN(b.x)], 1u);
            asm volatile("s_waitcnt vmcnt(0)" ::: "memory");
        } else {
            XB_SPIN(xb_ld(&bar[XB_XGEN(b.x)]) == gen, bar);
            __builtin_amdgcn_fence(__ATOMIC_ACQUIRE, "agent");
            asm volatile("s_waitcnt vmcnt(0)" ::: "memory");
        }
    }
    __syncthreads();
}

#ifndef PH_MASK
#define PH_MASK 0xffff
#endif
#define PHON(k) ((PH_MASK >> (k)) & 1)
#ifndef PH_REP
#define PH_REP 0ull
#endif
#ifndef SYNC_EXTRA
#define SYNC_EXTRA 0
#endif
#define REPN(k) (1 + (int)((PH_REP >> (2 * (k))) & 3ull))
__device__ __forceinline__ void run_phase(const Args& a, int p, LAS unsigned char* lds) {
    if (p == 0) { if (PHON(0)) prep_phase(a, lds); return; }
    const int l = (p - 1) >> 4, q = (p - 1) & 15;
    unsigned char* wl = a.ws + WS_W + (size_t)l * W_LAYER;
    bf16* XB = (bf16*)(a.ws + WS_XB); bf16* Hh = (bf16*)(a.ws + WS_H); bf16* Y = (bf16*)(a.ws + WS_Y); bf16* MB = (bf16*)(a.ws + WS_MB);
    const float alpha = 1.4142135623730951f;
    if (q < 12) {
        const int hb = q / 6, s = q % 6;
        if (s == 0) { if (PHON(1)) { pg8::Gemm g{XB + (size_t)hb * TH * DM, (const bf16*)(wl + WIN_OFF), TH, HP, DM}; pg8::StaticOrder S; S.init(TH, HP, gridDim.x, obid());
            pg8::EpiH E{Hh}; pg8::gemm_phase<pg8::EpiH, pg8::StaticOrder, PG8_ALIGN, PG8_SP2>(lds, g, S, E); } }
        else if (s == 1) { for (int r_ = 0; r_ < REPN(2); ++r_) { if (PHON(2)) gmlp_phase(a, l, lds); if (PHON(3)) fprep_phase(a, l); if (PHON(4)) hgrn1_phase(a, l, lds); } }
        else if (s == 2) { if (PHON(5)) hgrn2_phase(a); for (int r_ = 0; r_ < REPN(6); ++r_) if (PHON(6)) attn_phase(a, lds); }
        else if (s == 3) { for (int r_ = 0; r_ < REPN(7); ++r_) if (PHON(7)) hgrn3_phase(a, l, lds); }
        else if (s == 4) { if (PHON(8)) { pg8::Gemm g{Y, (const bf16*)(wl + WP_OFF), 3 * TH, 3 * DM, 512}; pg8::ProjOrder S{(int)gridDim.x, obid()};
            pg8::EpiProj E{Hh, MB}; pg8::gemm_phase<pg8::EpiProj, pg8::ProjOrder, PG8_ALIGN, PG8_SP2>(lds, g, S, E); } }
        else { if (PHON(9)) { pg8::Gemm g{MB, (const bf16*)(wl + WO_OFF), TH, DM, DM}; pg8::StaticOrder S; S.init(TH, DM, gridDim.x, obid());
            const float* base = (l == 0 ? a.x : a.out) + (size_t)hb * TH * DM;
            pg8::EpiResid E{base, a.out + (size_t)hb * TH * DM, alpha}; pg8::gemm_phase<pg8::EpiResid, pg8::StaticOrder, PG8_ALIGN, PG8_SP2>(lds, g, S, E); } }
        return;
    }
    if (q == 12) { if (PHON(10)) ln_phase(a.out, a.ln1_g + l * DM, a.ln1_b + l * DM, XB); return; }
    if (q == 13) { if (PHON(11)) { pg8::Gemm g{XB, (const bf16*)(wl + WGU_OFF), T_ALL, 2 * DFF, DM}; pg8::StaticOrder S; S.init(T_ALL, 2 * DFF, gridDim.x, obid());
        pg8::EpiSwiglu E{Hh}; pg8::gemm_phase<pg8::EpiSwiglu, pg8::StaticOrder, PG8_ALIGN, PG8_SP2>(lds, g, S, E); } return; }
    if (q == 14) { if (PHON(12)) { pg8::Gemm g{Hh, (const bf16*)(wl + WD_OFF), T_ALL, DM, DFF}; pg8::StaticOrder S; S.init(T_ALL, DM, gridDim.x, obid());
        pg8::EpiResid E{a.out, a.out, alpha}; pg8::gemm_phase<pg8::EpiResid, pg8::StaticOrder, PG8_ALIGN, PG8_SP2>(lds, g, S, E); } return; }
    if (PHON(10)) ln_phase(a.out, a.ln2_g + l * DM, a.ln2_b + l * DM, XB);
}
__global__ void __launch_bounds__(512, 2) mega(Args a) {
    extern __shared__ __attribute__((aligned(16))) unsigned char lds_raw[];
    LAS unsigned char* lds = (LAS unsigned char*)lds_raw;
    cg::grid_group grid = cg::this_grid();
    volatile LAS unsigned* misc = (volatile LAS unsigned*)(lds + 131072 + 256);
    XcdBarrier bar; bar.bar = (unsigned*)(a.ws + WS_CTL); bar.x = 0; bar.st = nullptr;
    if (a.hi - a.lo > 1) {
        if (threadIdx.x < 16) misc[threadIdx.x] = 0u;
        __syncthreads();
        bar = xcd_barrier_post((unsigned*)(a.ws + WS_CTL), misc + 8);
    }
    for (int p = a.lo; p < a.hi; ++p) {
        Args b = a; asm volatile("" : "+s"(b.ws), "+s"(b.out));
        run_phase(b, p, lds);
        if (p + 1 < a.hi) { if (p == a.lo) grid.sync(); else xcd_barrier(bar); for (int e_ = 0; e_ < SYNC_EXTRA; ++e_) xcd_barrier(bar); }
    }
}

#ifndef MK_DEBUG
#define MK_DEBUG 0
#endif
#if MK_DEBUG
__global__ void __launch_bounds__(256) dbg_check(const unsigned* base, size_t nwords, int type, unsigned long long* ctl, int p, int rep, int r) {
    unsigned long long cs = 0ull, nf = 0ull;
    for (size_t i = (size_t)blockIdx.x * 256 + threadIdx.x; i < nwords; i += (size_t)gridDim.x * 256) { const unsigned w = base[i];
        cs += (unsigned long long)w * (2ull * i + 1ull);
        if (type == 1) { if ((w & 0x7f800000u) >= (141u << 23)) ++nf; } else { if ((w & 0x7f80u) >= (141u << 7)) ++nf; if ((w & 0x7f800000u) >= (141u << 23)) ++nf; } }
    for (int o = 1; o < 64; o <<= 1) { cs += __shfl_xor(cs, o); nf += __shfl_xor(nf, o); }
    if ((threadIdx.x & 63) == 0) { atomicAdd(ctl + 64 + (rep * 64 + p) * 4 + r, cs); if (nf) atomicAdd(ctl + p, nf); }
}
__global__ void __launch_bounds__(256) dbg_report(const unsigned long long* ctl, float* out, size_t n) {
    int code = 0;
    if (ctl[40]) code = 90;
    for (int p = 0; p < NPHASE && !code; ++p) { if (ctl[p]) code = 3 + p; else for (int r = 0; r < 4; ++r) if (ctl[64 + p * 4 + r] != ctl[64 + (64 + p) * 4 + r]) code = 40 + p; }
    if (!code) return;
    for (size_t i = (size_t)blockIdx.x * 256 + threadIdx.x; i < n; i += (size_t)gridDim.x * 256) out[i] = (float)code;
}
__global__ void __launch_bounds__(256) dbg_g1(const float* w_in, const unsigned char* ws, unsigned long long* ctl, int hb) {
    const unsigned hsh = (blockIdx.x + 1u) * 2654435761u; const int row = (hsh >> 8) % TH; const int n = 1024 + (int)((hsh * 40503u >> 4) % (INC - 1024));
    const bf16* XB = (const bf16*)(ws + WS_XB) + ((size_t)hb * TH + row) * DM; const bf16* H = (const bf16*)(ws + WS_H);
    float s = 0.f; for (int k = threadIdx.x; k < DM; k += 256) s += bf2f(XB[k]) * w_in[(size_t)k * INC + n];
    __shared__ float red[256]; red[threadIdx.x] = s; __syncthreads();
    if (threadIdx.x == 0) { float t = 0.f; for (int i = 0; i < 256; ++i) t += red[i]; if (n >= 3072 && n < 3584) t *= pg8::QSCALE;
        const float got = bf2f(H[(size_t)row * HP + rowmap(1, n)]); if (!(fabsf(got - t) <= 0.03f + 0.03f * fabsf(t))) atomicAdd(ctl + 40, 1ull); }
}
struct DbgReg { size_t off; size_t bytes; int type; int in_out; };
static int dbg_regions(int p, DbgReg* R) {
    if (p == 0) { R[0] = {WS_W, WS_H - WS_W, 0, 0}; return 1; }
    const int q = (p - 1) & 15;
    if (q < 12) { const int hb = q / 6, s = q % 6;
        if (s == 0) { R[0] = {WS_H, 248 * MiB, 0, 0}; return 1; }
        if (s == 1) { R[0] = {WS_Y, 16 * MiB, 0, 0}; R[1] = {WS_U, 32 * MiB, 0, 0}; R[2] = {WS_DEC, 1 * MiB, 1, 0}; return 3; }
        if (s == 2) { R[0] = {WS_U, 32 * MiB, 0, 0}; R[1] = {WS_Y + 32 * MiB, 16 * MiB, 0, 0}; return 2; }
        if (s == 3) { R[0] = {WS_Y + 16 * MiB, 16 * MiB, 0, 0}; return 1; }
        if (s == 4) { R[0] = {WS_MB, 32 * MiB, 0, 0}; return 1; }
        R[0] = {(size_t)hb * 64 * MiB, 64 * MiB, 1, 1}; return 1; }
    if (q == 13) { R[0] = {WS_H, 176 * MiB, 0, 0}; return 1; }
    if (q == 14) { R[0] = {0, 128 * MiB, 1, 1}; return 1; }
    R[0] = {0, 128 * MiB, 1, 1}; R[1] = {WS_XB, 64 * MiB, 0, 0}; return 2;
}
#endif
#ifndef MK_MULTI
#define MK_MULTI 0
#endif
extern "C" void kernel_launch(void* const* d_in, const int* in_sizes, int n_in, void* d_out, int out_size, void* d_ws, size_t ws_size, hipStream_t stream) {
    static int grid = 0;
    if (grid == 0) {
        if (n_in != 20 || out_size != T_ALL * DM || ws_size < WS_END) { fprintf(stderr, "kernel_launch: unexpected shapes (n_in %d out %d ws %zu)\n", n_in, out_size, ws_size); grid = -1; return; }
        if (hipFuncSetAttribute((const void*)mega, hipFuncAttributeMaxDynamicSharedMemorySize, LDS_BYTES) != hipSuccess) { fprintf(stderr, "kernel_launch: hipFuncSetAttribute failed\n"); grid = -1; return; }
        int dev = 0, cus = 0, per_cu = 0;
        (void)hipGetDevice(&dev); (void)hipDeviceGetAttribute(&cus, hipDeviceAttributeMultiprocessorCount, dev);
        (void)hipOccupancyMaxActiveBlocksPerMultiprocessor(&per_cu, (const void*)mega, 512, LDS_BYTES);
        if (per_cu < 1) per_cu = 1;
        grid = cus;
        (void)hipGetLastError();
    }
    if (grid < 0) return;
    Args a{};
    const float** ap = (const float**)&a;
    for (int i = 0; i < 20; ++i) ap[i] = (const float*)d_in[i];
    a.out = (float*)d_out; a.ws = (unsigned char*)d_ws;
#if MK_DEBUG
    (void)hipMemsetAsync(d_ws, 0xAA, WS_END, stream); (void)hipMemsetAsync(d_out, 0xAA, (size_t)T_ALL * DM * 4, stream); (void)hipMemsetAsync(d_ws, 0, 1 * MiB, stream);
    for (int rep = 0; rep < 2; ++rep)
        for (int p = 0; p < NPHASE; ++p) { a.lo = p; a.hi = p + 1; hipLaunchKernelGGL(mega, dim3(grid), dim3(512), LDS_BYTES, stream, a);
            if (p == 1 && rep == 0) hipLaunchKernelGGL(dbg_g1, dim3(2048), dim3(256), 0, stream, (const float*)d_in[1], (const unsigned char*)d_ws, (unsigned long long*)d_ws, 0);
            DbgReg R[4]; const int nr = dbg_regions(p, R);
            for (int r = 0; r < nr; ++r) hipLaunchKernelGGL(dbg_check, dim3(1024), dim3(256), 0, stream, (const unsigned*)((R[r].in_out ? (unsigned char*)d_out : (unsigned char*)d_ws) + R[r].off), R[r].bytes / 4, R[r].type, (unsigned long long*)d_ws, p, rep, r); }
    hipLaunchKernelGGL(dbg_report, dim3(1024), dim3(256), 0, stream, (const unsigned long long*)d_ws, (float*)d_out, (size_t)T_ALL * DM);
#elif MK_MULTI
    for (int p = 0; p < NPHASE; ++p) { a.lo = p; a.hi = p + 1; hipLaunchKernelGGL(mega, dim3(grid), dim3(512), LDS_BYTES, stream, a); }
#else
    a.lo = 0; a.hi = NPHASE;
    (void)hipMemsetAsync(d_ws, 0, 65536, stream);
    void* args[] = {&a};
    hipError_t e = hipLaunchCooperativeKernel((const void*)mega, dim3(grid), dim3(512), args, LDS_BYTES, stream);
    if (e != hipSuccess) fprintf(stderr, "cooperative launch failed: %s (grid %d)\n", hipGetErrorString(e), grid);
#endif
}
```

```cpp
#include <hip/hip_cooperative_groups.h>
#include <hip/hip_runtime.h>
#include <cstdio>
#include <cstdint>
__device__ __forceinline__ int otid() { int t = threadIdx.x; asm volatile("" : "+v"(t)); return t; }
__device__ __forceinline__ int obid() { int b = blockIdx.x; asm volatile("" : "+s"(b)); return b; }
namespace pg8 {
#define PG8_LAS __attribute__((address_space(3)))
typedef unsigned short bf16_t;
typedef short bf16x8 __attribute__((ext_vector_type(8)));
typedef float f32x4 __attribute__((ext_vector_type(4)));
typedef unsigned u32x4 __attribute__((ext_vector_type(4)));
constexpr int BM = 256, BK = 64, HALF = 128, HTB = HALF * BK * 2  , STAGE_BYTES = 8 * HTB, NXCD = 8, WGM = 8;

__host__ __device__ __forceinline__ int lds_byte(int r, int c) { const int st = (r >> 4) * 2 + (c >> 5), rr = r & 15, cc = c & 31, ob = rr * 64 + cc * 2; return st * 1024 + (ob ^ (((ob >> 9) & 1) << 5)); }
__host__ __device__ __forceinline__ void stage_rc(int b, int& R, int& C) { const int st = b / 1024, sb = b % 1024, swz = sb ^ (((sb >> 9) & 1) << 5); R = (st >> 1) * 16 + swz / 64; C = (st & 1) * 32 + (swz % 64) / 2; }
__host__ __device__ __forceinline__ int perm32(int rho) { const int n = rho >> 4, i = rho & 15; return 8 * (i >> 2) + 4 * n + (i & 3); }

struct Unit { int pm, pn; };
struct Gemm { const bf16_t* A; const bf16_t* Bt; int M, N, K; };

struct StaticOrder {
    int nM, nN, nwg, G, c;
    __host__ __device__ void init(int M, int N, int G_, int c_) { nM = M / BM; nN = N / BM; nwg = nM * nN; G = G_; c = c_; }
    __host__ __device__ bool next(int i, Unit& u) const {
        const long L = (long)i * G + c; if (L >= nwg) return false;
        int wgid = (int)L; { const int q = nwg / NXCD, r = nwg % NXCD, xcd = wgid % NXCD, off = wgid / NXCD; wgid = (xcd < r ? xcd * (q + 1) : r * (q + 1) + (xcd - r) * q) + off; }
        const int nig = WGM * nN, gid = wgid / nig, fm = gid * WGM, gsz = (nM - fm) < WGM ? (nM - fm) : WGM;
        u.pm = fm + ((wgid % nig) % gsz); u.pn = (wgid % nig) / gsz; return true;
    }
    __device__ __forceinline__ void a_ready(const Unit&) const {}
    __device__ __forceinline__ void done(const Unit&) const {}
};

typedef float f32x2c_t __attribute__((ext_vector_type(2))); typedef __bf16 bf16x2c_t __attribute__((ext_vector_type(2)));
__device__ __forceinline__ unsigned cvt_pk_bf16(float lo, float hi) { f32x2c_t v = {lo, hi}; bf16x2c_t b = __builtin_convertvector(v, bf16x2c_t); return __builtin_bit_cast(unsigned, b); }
typedef float f32x2 __attribute__((ext_vector_type(2)));
__device__ __forceinline__ f32x2 gelu_pk(f32x2 v) {
    const f32x2 av = __builtin_elementwise_abs(v), d = av * 0.2316418882f + 1.0f;
    f32x2 t; t.x = __builtin_amdgcn_rcpf(d.x); t.y = __builtin_amdgcn_rcpf(d.y);
    f32x2 q = t * 0.5307027145f + (-0.7265760135f); q = q * t + 0.7107068705f; q = q * t + (-0.142248368f); q = q * t + 0.127414796f; q = q * t;
    const f32x2 s = (v * v) * (-0.72134752044f);
    f32x2 e; e.x = __builtin_amdgcn_exp2f(s.x); e.y = __builtin_amdgcn_exp2f(s.y);
    const f32x2 m = v * (q * e), r = v - m;
    f32x2 o; o.x = v.x < 0.f ? m.x : r.x; o.y = v.y < 0.f ? m.y : r.y; return o;
}

constexpr int HPITCH = 7936;
constexpr float QSCALE = 0.125f * 1.4426950408889634f;
__device__ __forceinline__ float bflo(unsigned w) { return __uint_as_float(w << 16); }
__device__ __forceinline__ float bfhi(unsigned w) { return __uint_as_float(w & 0xffff0000u); }
__device__ __forceinline__ float sigm(float x) { return 1.0f / (1.0f + __expf(-x)); }
struct EpiH {
    static constexpr bool PERM = true, AFTER_DRAIN = false;
    bf16_t* O;
    __device__ __forceinline__ void operator()(const f32x4 (&acc)[2][2][4][2], const Unit& u, int wr, int wc, int fr, int fq) const {
        const int row0 = u.pm * BM + wr * 64 + fr; const int col0 = u.pn * BM + wc * 32 + 8 * fq;
        const bool dogelu = u.pn < 4; const float sc = (u.pn == 12 || u.pn == 13) ? QSCALE : 1.f;
#pragma unroll
        for (int ai = 0; ai < 2; ++ai)
#pragma unroll
            for (int m = 0; m < 4; ++m) { bf16_t* rowp = O + (size_t)(row0 + ai * HALF + m * 16) * HPITCH + col0;
#pragma unroll
                for (int bj = 0; bj < 2; ++bj) { f32x4 v0 = acc[ai][bj][m][0], v1 = acc[ai][bj][m][1];
                    if (dogelu) { f32x2 a = gelu_pk((f32x2){v0[0], v0[1]}), b = gelu_pk((f32x2){v0[2], v0[3]}), c = gelu_pk((f32x2){v1[0], v1[1]}), d = gelu_pk((f32x2){v1[2], v1[3]});
                        v0 = (f32x4){a.x, a.y, b.x, b.y}; v1 = (f32x4){c.x, c.y, d.x, d.y}; }
                    v0 = v0 * sc; v1 = v1 * sc; u32x4 w; w.x = cvt_pk_bf16(v0[0], v0[1]); w.y = cvt_pk_bf16(v0[2], v0[3]); w.z = cvt_pk_bf16(v1[0], v1[1]); w.w = cvt_pk_bf16(v1[2], v1[3]);
                    *(u32x4*)(rowp + bj * HALF) = w; } }
    }
};
struct EpiProj {
    static constexpr bool PERM = true, AFTER_DRAIN = false;
    const bf16_t* Hh; bf16_t* MB;
    __device__ __forceinline__ void operator()(const f32x4 (&acc)[2][2][4][2], const Unit& u, int wr, int wc, int fr, int fq) const {
        const int br = u.pn >> 2, pnn = u.pn & 3, pmm = u.pm & 63;
        const int row0 = pmm * BM + wr * 64 + fr; const int col0 = pnn * BM + wc * 32 + 8 * fq;
#pragma unroll
        for (int ai = 0; ai < 2; ++ai)
#pragma unroll
            for (int m = 0; m < 4; ++m) { const size_t row = (size_t)(row0 + ai * HALF + m * 16);
#pragma unroll
                for (int bj = 0; bj < 2; ++bj) { const int col = col0 + bj * HALF;
                    const u32x4 gw = *(const u32x4*)(Hh + row * HPITCH + 4608 + br * 1024 + col);
                    const f32x4 v0 = acc[ai][bj][m][0], v1 = acc[ai][bj][m][1];
                    float r0 = sigm(bflo(gw.x)) * v0[0], r1 = sigm(bfhi(gw.x)) * v0[1], r2 = sigm(bflo(gw.y)) * v0[2], r3 = sigm(bfhi(gw.y)) * v0[3];
                    float r4 = sigm(bflo(gw.z)) * v1[0], r5 = sigm(bfhi(gw.z)) * v1[1], r6 = sigm(bflo(gw.w)) * v1[2], r7 = sigm(bfhi(gw.w)) * v1[3];
                    bf16_t* mp = MB + row * 1024 + col;
                    if (br > 0) { const u32x4 o = *(const u32x4*)mp; r0 += bflo(o.x); r1 += bfhi(o.x); r2 += bflo(o.y); r3 += bfhi(o.y); r4 += bflo(o.z); r5 += bfhi(o.z); r6 += bflo(o.w); r7 += bfhi(o.w); }
                    u32x4 w; w.x = cvt_pk_bf16(r0, r1); w.y = cvt_pk_bf16(r2, r3); w.z = cvt_pk_bf16(r4, r5); w.w = cvt_pk_bf16(r6, r7);
                    *(u32x4*)mp = w; } }
    }
};
struct EpiResid {
    static constexpr bool PERM = false, AFTER_DRAIN = false;
    const float* base; float* out; float alpha;
    __device__ __forceinline__ void operator()(const f32x4 (&acc)[2][2][4][2], const Unit& u, int wr, int wc, int fr, int fq) const {
        const int row0 = u.pm * BM + wr * 64 + fr; const int col0 = u.pn * BM + wc * 32 + 4 * fq;
#pragma unroll
        for (int ai = 0; ai < 2; ++ai)
#pragma unroll
            for (int m = 0; m < 4; ++m) { const size_t off = (size_t)(row0 + ai * HALF + m * 16) * 1024 + col0;
#pragma unroll
                for (int bj = 0; bj < 2; ++bj)
#pragma unroll
                    for (int n = 0; n < 2; ++n) { const f32x4 b = *(const f32x4*)(base + off + bj * HALF + n * 16); *(f32x4*)(out + off + bj * HALF + n * 16) = b * alpha + acc[ai][bj][m][n]; } }
    }
};
struct EpiSwiglu {
    static constexpr bool PERM = true, AFTER_DRAIN = false;
    bf16_t* O;
    __device__ __forceinline__ void operator()(const f32x4 (&acc)[2][2][4][2], const Unit& u, int wr, int wc, int fr, int fq) const {
        const int row0 = u.pm * BM + wr * 64 + fr; const int col0 = u.pn * HALF + wc * 32 + 8 * fq;
#pragma unroll
        for (int ai = 0; ai < 2; ++ai)
#pragma unroll
            for (int m = 0; m < 4; ++m) { const f32x4 g0 = acc[ai][0][m][0], g1 = acc[ai][0][m][1], u0 = acc[ai][1][m][0], u1 = acc[ai][1][m][1];
                u32x4 w; w.x = cvt_pk_bf16(g0[0] * sigm(g0[0]) * u0[0], g0[1] * sigm(g0[1]) * u0[1]); w.y = cvt_pk_bf16(g0[2] * sigm(g0[2]) * u0[2], g0[3] * sigm(g0[3]) * u0[3]);
                w.z = cvt_pk_bf16(g1[0] * sigm(g1[0]) * u1[0], g1[1] * sigm(g1[1]) * u1[1]); w.w = cvt_pk_bf16(g1[2] * sigm(g1[2]) * u1[2], g1[3] * sigm(g1[3]) * u1[3]);
                *(u32x4*)(O + (size_t)(row0 + ai * HALF + m * 16) * 2816 + col0) = w; }
    }
};
struct ProjOrder {
    int G, c;
    __device__ __forceinline__ bool next(int i, Unit& u) const { const int tile = c + (i / 3) * G; if (tile >= 256) return false; const int br = i % 3; u.pm = br * 64 + (tile >> 2); u.pn = br * 4 + (tile & 3); return true; }
    __device__ __forceinline__ void a_ready(const Unit&) const {}
    __device__ __forceinline__ void done(const Unit&) const {}
};
template <class Epi, class Sched, bool ALIGN_EPI = false, bool SP2 = false>
__device__ __forceinline__ void gemm_phase(PG8_LAS unsigned char* lds, const Gemm g, const Sched& S, const Epi& E) {
    const int tid = otid(), wid = __builtin_amdgcn_readfirstlane(tid >> 6), lane = tid & 63, wr = wid >> 2, wc = wid & 3, fr = lane & 15, fq = lane >> 4;
    const int K = g.K, nt = K / BK;
    unsigned voffA[2], voffB[2];
#pragma unroll
    for (int i = 0; i < 2; ++i) { int R, C; stage_rc(tid * 16 + i * 8192, R, C); const int Rb = Epi::PERM ? ((R & ~31) + perm32(R & 31)) : R;
        voffA[i] = (unsigned)(R * K + C) * 2u; voffB[i] = (unsigned)(Rb * K + C) * 2u; }
    const size_t kstep = (size_t)(BK * 2);
    const size_t hstep = (size_t)HALF * K * 2;
    const size_t tstep = 2 * hstep;
    const unsigned ldsw = (unsigned)wid * 1024u;
    const int aoff = lds_byte(wr * 64 + fr, fq * 8), boff = lds_byte(wc * 32 + fr, fq * 8);
#define PG8_SA(b, h) (((b) * 2 + (h)) * HTB)
#define PG8_SB(b, h) ((4 + (b) * 2 + (h)) * HTB)
#define PG8_STAGE(bufoff, gbase, voff) do { _Pragma("unroll") for (int _i = 0; _i < 2; ++_i) \
        __builtin_amdgcn_global_load_lds((const unsigned*)((const char*)(gbase) + (voff)[_i]), (PG8_LAS unsigned*)(lds + (bufoff) + ldsw + _i * 8192), 16, 0, 0); } while (0)
#define PG8_LDA(dst, b, h) do { _Pragma("unroll") for (int m = 0; m < 4; ++m) _Pragma("unroll") for (int k = 0; k < 2; ++k) dst[m][k] = *(const PG8_LAS bf16x8*)(lds + PG8_SA(b, h) + aoff + m * 2048 + k * 1024); } while (0)
#define PG8_LDB(dst, b, h) do { _Pragma("unroll") for (int n = 0; n < 2; ++n) _Pragma("unroll") for (int k = 0; k < 2; ++k) dst[n][k] = *(const PG8_LAS bf16x8*)(lds + PG8_SB(b, h) + boff + n * 2048 + k * 1024); } while (0)
#define PG8_MMA(ai, bj, At, Bt) do { __builtin_amdgcn_s_setprio(1); _Pragma("unroll") for (int m = 0; m < 4; ++m) _Pragma("unroll") for (int n = 0; n < 2; ++n) _Pragma("unroll") for (int k = 0; k < 2; ++k) \
        acc[ai][bj][m][n] = __builtin_amdgcn_mfma_f32_16x16x32_bf16(Bt[n][k], At[m][k], acc[ai][bj][m][n], 0, 0, 0); __builtin_amdgcn_s_setprio(0); } while (0)
#define PG8_WAIT_V(n) asm volatile("s_waitcnt vmcnt(" #n ")" ::: "memory")
#define PG8_WAIT_L(n) asm volatile("s_waitcnt lgkmcnt(" #n ")" ::: "memory")
#define PG8_BAR __builtin_amdgcn_s_barrier()
#define PG8_SCHED __builtin_amdgcn_sched_barrier(0)
    Unit cur, nxt; int ui = 0;
    if (!S.next(0, cur)) return;
    f32x4 acc[2][2][4][2];
#pragma unroll
    for (int a = 0; a < 2; ++a)
#pragma unroll
        for (int b = 0; b < 2; ++b)
#pragma unroll
            for (int m = 0; m < 4; ++m)
#pragma unroll
                for (int n = 0; n < 2; ++n) acc[a][b][m][n] = (f32x4){0.f, 0.f, 0.f, 0.f};
    bf16x8 At[4][2], B0[2][2], B1[2][2];
    const char* cA = (const char*)g.A + (size_t)cur.pm * tstep; const char* cB = (const char*)g.Bt + (size_t)cur.pn * tstep;
    S.a_ready(cur);
    if constexpr (SP2) {
        PG8_STAGE(PG8_SB(0, 0), cB, voffB); PG8_STAGE(PG8_SB(0, 1), cB + hstep, voffB); PG8_STAGE(PG8_SA(0, 0), cA, voffA); PG8_STAGE(PG8_SA(0, 1), cA + hstep, voffA);
        if (wr == 1) PG8_BAR;
        PG8_WAIT_V(2); PG8_BAR;
        PG8_STAGE(PG8_SB(1, 0), cB + kstep, voffB); PG8_STAGE(PG8_SA(1, 0), cA + kstep, voffA); PG8_STAGE(PG8_SB(1, 1), cB + hstep + kstep, voffB);
        PG8_WAIT_V(6); PG8_BAR;
    } else {
        PG8_STAGE(PG8_SB(0, 0), cB, voffB); PG8_STAGE(PG8_SA(0, 0), cA, voffA); PG8_STAGE(PG8_SB(0, 1), cB + hstep, voffB); PG8_STAGE(PG8_SA(0, 1), cA + hstep, voffA);
        if (wr == 1) PG8_BAR;
        PG8_WAIT_V(4); PG8_BAR;
        PG8_STAGE(PG8_SB(1, 0), cB + kstep, voffB); PG8_STAGE(PG8_SA(1, 0), cA + kstep, voffA); PG8_STAGE(PG8_SB(1, 1), cB + hstep + kstep, voffB);
        PG8_WAIT_V(6); PG8_BAR;
    }
    for (;;) {
        const bool has_next = S.next(ui + 1, nxt);
        const char* nA = has_next ? (const char*)g.A + (size_t)nxt.pm * tstep : cA; const char* nB = has_next ? (const char*)g.Bt + (size_t)nxt.pn * tstep : cB;
        for (int t = 0; t < nt; t += 2) {
            const bool last = (t == nt - 2);
            const char* a1 = cA + (size_t)(t + 1) * kstep;
            const char* a2 = last ? nA : cA + (size_t)(t + 2) * kstep; const char* b2 = last ? nB : cB + (size_t)(t + 2) * kstep;
            const char* a3 = a2 + kstep; const char* b3 = b2 + kstep;
            if (last && has_next) S.a_ready(nxt);
            if constexpr (SP2) {
            PG8_LDB(B0, 0, 0); PG8_LDB(B1, 0, 1); PG8_SCHED; PG8_LDA(At, 0, 0); PG8_STAGE(PG8_SA(1, 1), a1 + hstep, voffA);
            PG8_WAIT_V(8); PG8_WAIT_L(0); PG8_BAR; PG8_MMA(0, 0, At, B0); PG8_MMA(0, 1, At, B1); PG8_BAR; PG8_SCHED;
            PG8_LDA(At, 0, 1); PG8_STAGE(PG8_SB(0, 0), b2, voffB); PG8_STAGE(PG8_SB(0, 1), b2 + hstep, voffB); PG8_STAGE(PG8_SA(0, 0), a2, voffA);
            PG8_WAIT_V(8); PG8_WAIT_L(0); PG8_BAR; PG8_MMA(1, 0, At, B0); PG8_MMA(1, 1, At, B1); PG8_BAR; PG8_SCHED;
            PG8_LDB(B0, 1, 0); PG8_LDB(B1, 1, 1); PG8_SCHED; PG8_LDA(At, 1, 0); PG8_STAGE(PG8_SA(0, 1), a2 + hstep, voffA);
            PG8_WAIT_V(8); PG8_WAIT_L(0); PG8_BAR; PG8_MMA(0, 0, At, B0); PG8_MMA(0, 1, At, B1); PG8_BAR; PG8_SCHED;
            PG8_LDA(At, 1, 1); PG8_STAGE(PG8_SB(1, 0), b3, voffB); PG8_STAGE(PG8_SB(1, 1), b3 + hstep, voffB); PG8_STAGE(PG8_SA(1, 0), a3, voffA);
            PG8_WAIT_V(8); PG8_WAIT_L(0); PG8_BAR; PG8_MMA(1, 0, At, B0); PG8_MMA(1, 1, At, B1); PG8_BAR; PG8_SCHED;
            } else {
            PG8_LDB(B0, 0, 0); PG8_SCHED; PG8_LDA(At, 0, 0); PG8_STAGE(PG8_SA(1, 1), a1 + hstep, voffA);
            PG8_WAIT_L(8); PG8_BAR; PG8_WAIT_L(0); PG8_MMA(0, 0, At, B0); PG8_BAR; PG8_SCHED;
            PG8_LDB(B1, 0, 1); PG8_STAGE(PG8_SB(0, 0), b2, voffB);
            PG8_BAR; PG8_WAIT_L(0); PG8_MMA(0, 1, At, B1); PG8_BAR;
            PG8_LDA(At, 0, 1); PG8_STAGE(PG8_SA(0, 0), a2, voffA);
            PG8_BAR; PG8_WAIT_L(0); PG8_MMA(1, 0, At, B0); PG8_BAR; PG8_SCHED;
            PG8_STAGE(PG8_SB(0, 1), b2 + hstep, voffB);
            PG8_WAIT_V(6); PG8_BAR; PG8_MMA(1, 1, At, B1); PG8_BAR;
            PG8_LDB(B0, 1, 0); PG8_SCHED; PG8_LDA(At, 1, 0); PG8_STAGE(PG8_SA(0, 1), a2 + hstep, voffA);
            PG8_WAIT_L(8); PG8_BAR; PG8_WAIT_L(0); PG8_MMA(0, 0, At, B0); PG8_BAR; PG8_SCHED;
            PG8_LDB(B1, 1, 1); PG8_STAGE(PG8_SB(1, 0), b3, voffB);
            PG8_BAR; PG8_WAIT_L(0); PG8_MMA(0, 1, At, B1); PG8_BAR;
            PG8_LDA(At, 1, 1); PG8_STAGE(PG8_SA(1, 0), a3, voffA);
            PG8_BAR; PG8_WAIT_L(0); PG8_MMA(1, 0, At, B0); PG8_BAR; PG8_SCHED;
            PG8_STAGE(PG8_SB(1, 1), b3 + hstep, voffB);
            PG8_WAIT_V(6); PG8_BAR; PG8_MMA(1, 1, At, B1); PG8_BAR;
            }
        }
        if constexpr (ALIGN_EPI) { if (wr == 0) PG8_BAR; }
        if constexpr (!Epi::AFTER_DRAIN) { E(acc, cur, wr, wc, fr, fq); S.done(cur); }
        if (!has_next) break;
#pragma unroll
        for (int a = 0; a < 2; ++a)
#pragma unroll
            for (int b = 0; b < 2; ++b)
#pragma unroll
                for (int m = 0; m < 4; ++m)
#pragma unroll
                    for (int n = 0; n < 2; ++n) acc[a][b][m][n] = (f32x4){0.f, 0.f, 0.f, 0.f};
        cur = nxt; cA = nA; cB = nB; ++ui;
        if constexpr (ALIGN_EPI) { if (wr == 1) PG8_BAR; }
    }
    PG8_WAIT_V(0);
    if constexpr (!ALIGN_EPI) { if (wr == 0) PG8_BAR; }
    PG8_BAR;
    if constexpr (Epi::AFTER_DRAIN) { E.fused(acc, cur, wr, wc, fr, fq, lds, wid, lane); S.done(cur); }
#undef PG8_SA
#undef PG8_SB
#undef PG8_STAGE
#undef PG8_LDA
#undef PG8_LDB
#undef PG8_MMA
#undef PG8_WAIT_V
#undef PG8_WAIT_L
#undef PG8_BAR
#undef PG8_SCHED
}
}

#ifndef PG8_SP2
#define PG8_SP2 true
#endif
#ifndef PG8_ALIGN
#define PG8_ALIGN true
#endif
namespace cg = cooperative_groups;
#define LAS __attribute__((address_space(3)))
typedef unsigned short bf16;
typedef short bf16x8 __attribute__((ext_vector_type(8)));
typedef float f32x4 __attribute__((ext_vector_type(4)));
typedef float f32x16 __attribute__((ext_vector_type(16)));
typedef unsigned u32x4 __attribute__((ext_vector_type(4)));
typedef unsigned u32x2 __attribute__((ext_vector_type(2)));
using pg8::bflo; using pg8::bfhi; using pg8::sigm; using pg8::cvt_pk_bf16;

constexpr int T_ALL = 32768, TH = 16384, DM = 1024, SEQ = 4096, HP = pg8::HPITCH, DFF = 2816, INC = 7688;
constexpr int C_GU = 0, C_GV = 512, C_RQ = 1024, C_RF = 1536, C_RI = 2048, C_RG = 2560, C_AQ = 3072, C_AK = 3584, C_AV = 4096, C_GATE = 4608, C_AF = 7680;
constexpr float LOG2E = 1.4426950408889634f;
constexpr size_t MiB = 1u << 20;
constexpr size_t WS_CTL = 0, WS_W = 1 * MiB, W_LAYER = 37 * MiB;
constexpr size_t WIN_OFF = 0, WP_OFF = 16252928, WO_OFF = WP_OFF + 3145728, WGU_OFF = WO_OFF + 2097152, WD_OFF = WGU_OFF + 11534336;
static_assert(WD_OFF + 5767168 == W_LAYER, "weight map");
constexpr size_t WS_XB = 75 * MiB, WS_H = 139 * MiB, WS_Y = 387 * MiB, WS_MB = 435 * MiB, WS_U = 467 * MiB, WS_DEC = 499 * MiB, WS_GF = WS_DEC + 512 * 1024, WS_END = 500 * MiB;
constexpr int LDS_BYTES = 147456;
#define RLX_AGENT __ATOMIC_RELAXED, __HIP_MEMORY_SCOPE_AGENT
constexpr int NPHASE = 33;

struct Args {
    const float *x, *w_in, *gln_g, *gln_b, *g_ws, *g_bs, *lb_logits, *r_norm_w, *fox_fb, *w_pg, *w_pr, *w_pa, *w_o, *ln1_g, *ln1_b, *w_gate, *w_up, *w_down, *ln2_g, *ln2_b;
    float* out; unsigned char* ws; int lo, hi;
};

__device__ __forceinline__ unsigned short f2bf(float f) { unsigned u = __float_as_uint(f); return (unsigned short)((u + 0x7fffu + ((u >> 16) & 1u)) >> 16); }
__device__ __forceinline__ float bf2f(unsigned short b) { return __uint_as_float((unsigned)b << 16); }
__device__ __forceinline__ float wave_sum(float v) {
#pragma unroll
    for (int o = 1; o < 64; o <<= 1) v += __shfl_xor(v, o);
    return v;
}
__device__ __forceinline__ f32x4 mfma16(bf16x8 a, bf16x8 b, f32x4 c) { return __builtin_amdgcn_mfma_f32_16x16x32_bf16(a, b, c, 0, 0, 0); }
__device__ __forceinline__ f32x16 mfma32(bf16x8 a, bf16x8 b, f32x16 c) { return __builtin_amdgcn_mfma_f32_32x32x16_bf16(a, b, c, 0, 0, 0); }

__device__ __forceinline__ int rowmap(int mode, int n) {
    if (mode == 1) return n < 4608 ? n : (n < 4616 ? 7680 + (n - 4608) : 4608 + (n - 4616));
    if (mode == 2) return (n >> 7) * 256 + (n & 127);
    if (mode == 3) return (n >> 7) * 256 + 128 + (n & 127);
    return n;
}
__device__ __forceinline__ void transpose_item(const float* W, int K, int N, bf16* WT, int mode, int row_off, LAS float* scr, int item, int lane) {
    const int nblk = (N + 31) / 32, kb = item / nblk, nb = item % nblk, k0 = 64 * kb, n0 = 32 * nb;
    const int nn = n0 + (lane & 31);
#pragma unroll 8
    for (int i = 0; i < 32; ++i) { const int kk = 2 * i + (lane >> 5); scr[kk * 33 + (lane & 31)] = nn < N ? W[(size_t)(k0 + kk) * N + nn] : 0.f; }
    asm volatile("s_waitcnt lgkmcnt(0)" ::: "memory");
    const int c = lane & 7;
#pragma unroll
    for (int j = 0; j < 4; ++j) { const int n = (lane >> 3) + 8 * j; const LAS float* s = scr + (8 * c) * 33 + n;
        u32x4 o; o.x = cvt_pk_bf16(s[0 * 33], s[1 * 33]); o.y = cvt_pk_bf16(s[2 * 33], s[3 * 33]); o.z = cvt_pk_bf16(s[4 * 33], s[5 * 33]); o.w = cvt_pk_bf16(s[6 * 33], s[7 * 33]);
        if (n0 + n < N) *(u32x4*)(WT + (size_t)(row_off + rowmap(mode, n0 + n)) * K + k0 + 8 * c) = o; }
    asm volatile("s_waitcnt lgkmcnt(0)" ::: "memory");
}
__device__ __forceinline__ void prep_phase(const Args& a, LAS unsigned char* lds) {
    const int tid = otid(), lane = tid & 63, wave = tid >> 6;
    const int gw = obid() * 8 + wave, NGW = gridDim.x * 8;
    LAS float* scr = (LAS float*)(lds + wave * 16384);
    constexpr int I_IN = 16 * 241, I_P = 8 * 32, I_O = 16 * 32, I_G = 16 * 88, I_D = 44 * 32;
    constexpr int PER_L = I_IN + 3 * I_P + I_O + 2 * I_G + I_D;
    for (int it = gw; it < 2 * PER_L; it += NGW) {
        const int l = it / PER_L; int r = it % PER_L;
        unsigned char* wl = a.ws + WS_W + (size_t)l * W_LAYER;
        if (r < I_IN) { transpose_item(a.w_in + (size_t)l * 1024 * INC, 1024, INC, (bf16*)(wl + WIN_OFF), 1, 0, scr, r, lane); continue; } r -= I_IN;
        if (r < I_P) { transpose_item(a.w_pg + (size_t)l * 512 * 1024, 512, 1024, (bf16*)(wl + WP_OFF), 0, 0, scr, r, lane); continue; } r -= I_P;
        if (r < I_P) { transpose_item(a.w_pr + (size_t)l * 512 * 1024, 512, 1024, (bf16*)(wl + WP_OFF), 0, 1024, scr, r, lane); continue; } r -= I_P;
        if (r < I_P) { transpose_item(a.w_pa + (size_t)l * 512 * 1024, 512, 1024, (bf16*)(wl + WP_OFF), 0, 2048, scr, r, lane); continue; } r -= I_P;
        if (r < I_O) { transpose_item(a.w_o + (size_t)l * 1024 * 1024, 1024, 1024, (bf16*)(wl + WO_OFF), 0, 0, scr, r, lane); continue; } r -= I_O;
        if (r < I_G) { transpose_item(a.w_gate + (size_t)l * 1024 * DFF, 1024, DFF, (bf16*)(wl + WGU_OFF), 2, 0, scr, r, lane); continue; } r -= I_G;
        if (r < I_G) { transpose_item(a.w_up + (size_t)l * 1024 * DFF, 1024, DFF, (bf16*)(wl + WGU_OFF), 3, 0, scr, r, lane); continue; } r -= I_G;
        transpose_item(a.w_down + (size_t)l * DFF * 1024, DFF, 1024, (bf16*)(wl + WD_OFF), 0, 0, scr, r, lane);
    }
    const int gt = obid() * 512 + tid, NGT = gridDim.x * 512;
    for (int i = gt; i < 2 * 31744; i += NGT) { const int l = i / 31744, j = i % 31744; ((u32x4*)(a.ws + WS_W + (size_t)l * W_LAYER + WIN_OFF + (size_t)7688 * 1024 * 2))[j] = (u32x4){0u, 0u, 0u, 0u}; }
    bf16* XB = (bf16*)(a.ws + WS_XB);
    for (int i = gt; i < T_ALL * DM / 4; i += NGT) { const f32x4 v = ((const f32x4*)a.x)[i]; u32x2 o; o.x = cvt_pk_bf16(v[0], v[1]); o.y = cvt_pk_bf16(v[2], v[3]); ((u32x2*)XB)[i] = o; }
}
__device__ __forceinline__ void ln_phase(float* X, const float* g, const float* b, bf16* XB) {
    const int tid = otid(), lane = tid & 63, wave = tid >> 6;
    const int gw = obid() * 8 + wave, NGW = gridDim.x * 8;
    for (int row = gw; row < T_ALL; row += NGW) {
        f32x4* xr = (f32x4*)(X + (size_t)row * DM) + lane;
        f32x4 v[4]; float s = 0.f;
#pragma unroll
        for (int j = 0; j < 4; ++j) { v[j] = xr[64 * j]; s += (v[j][0] + v[j][1]) + (v[j][2] + v[j][3]); }
        const float mean = wave_sum(s) * (1.f / DM); float s2 = 0.f;
#pragma unroll
        for (int j = 0; j < 4; ++j) { v[j] = v[j] - mean; s2 += (v[j][0] * v[j][0] + v[j][1] * v[j][1]) + (v[j][2] * v[j][2] + v[j][3] * v[j][3]); }
        const float rstd = 1.f / sqrtf(wave_sum(s2) * (1.f / DM) + 1e-5f);
        u32x2* o8 = (u32x2*)(XB + (size_t)row * DM) + lane;
#pragma unroll
        for (int j = 0; j < 4; ++j) { const f32x4 gg = ((const f32x4*)g)[lane + 64 * j], bb = ((const f32x4*)b)[lane + 64 * j]; const f32x4 o = v[j] * rstd * gg + bb;
            xr[64 * j] = o; u32x2 w; w.x = cvt_pk_bf16(o[0], o[1]); w.y = cvt_pk_bf16(o[2], o[3]); o8[64 * j] = w; }
    }
}
constexpr size_t WS_KN = 128 * 1024, WS_QN = 192 * 1024;
__device__ __forceinline__ void gmlp_load(const bf16* H, int u, int w, int lane, u32x4 (&vr)[16]) {
    const int n = (u >> 2) & 31, bl = u >> 7; const int r0 = bl * SEQ + n * 128;
#pragma unroll
    for (int i = 0; i < 16; ++i) vr[i] = *(const u32x4*)(H + (size_t)(r0 + w * 16 + i) * HP + C_GV + lane * 8);
}
__device__ __forceinline__ void gmlp_phase(const Args& a, int l, LAS unsigned char* lds) {
    const int tid = otid(), lane = tid & 63, w = tid >> 6, fr = lane & 15, fq = lane >> 4;
    const bf16* H = (const bf16*)(a.ws + WS_H);
    bf16* YG = (bf16*)(a.ws + WS_Y);
    LAS bf16* Wl = (LAS bf16*)lds;
    LAS bf16* vT = (LAS bf16*)(lds + 34816);
    const float* lng = a.gln_g + l * 512; const float* lnb = a.gln_b + l * 512;
    const float* wsp = a.g_ws + (size_t)l * 4 * 128 * 128; const float* bsp = a.g_bs + l * 4 * 128;
    const int G = gridDim.x;
    u32x4 vr[16];
    int u = obid();
    if (u < 512) gmlp_load(H, u, w, lane, vr);
    for (; u < 512; u += G) {
        const int g = u & 3, n = (u >> 2) & 31, bl = u >> 7;
        const int r0 = bl * SEQ + n * 128;
        const int wt = tid >> 2, seg = (tid & 3) * 32; const float* wp = wsp + (size_t)(g * 128 + wt) * 128 + seg;
        f32x4 wx[8];
#pragma unroll
        for (int j = 0; j < 8; ++j) wx[j] = *(const f32x4*)(wp + 4 * j);
        const int t = 16 * w + fr; const size_t hrow = (size_t)(r0 + t);
        u32x2 ur[8];
#pragma unroll
        for (int cb = 0; cb < 8; ++cb) ur[cb] = *(const u32x2*)(H + hrow * HP + C_GU + g * 128 + 16 * cb + 4 * fq);
        const float bsv = bsp[g * 128 + t];
        float lg8[8], lb8[8];
        { const int c0 = g * 128 + (lane & 15) * 8;
#pragma unroll
          for (int e = 0; e < 8; ++e) { lg8[e] = lng[c0 + e]; lb8[e] = lnb[c0 + e]; } }
#pragma unroll
        for (int i = 0; i < 16; ++i) {
            const int row = w * 16 + i; const u32x4 raw = vr[i];
            float f[8] = {bflo(raw.x), bfhi(raw.x), bflo(raw.y), bfhi(raw.y), bflo(raw.z), bfhi(raw.z), bflo(raw.w), bfhi(raw.w)};
            float s = 0.f;
#pragma unroll
            for (int e = 0; e < 8; ++e) s += f[e];
            const float mean = wave_sum(s) * (1.f / 512.f); float s2 = 0.f;
#pragma unroll
            for (int e = 0; e < 8; ++e) { f[e] -= mean; s2 += f[e] * f[e]; }
            const float rstd = 1.f / sqrtf(wave_sum(s2) * (1.f / 512.f) + 1e-5f);
            if ((lane >> 4) == g) { const int c0 = (lane & 15) * 8;
#pragma unroll
                for (int e = 0; e < 8; ++e) vT[(c0 + e) * 136 + row] = f2bf(f[e] * rstd * lg8[e] + lb8[e]); }
        }
        if (u + G < 512) gmlp_load(H, u + G, w, lane, vr);
#pragma unroll
        for (int j = 0; j < 4; ++j) { const f32x4 x0 = wx[2 * j], x1 = wx[2 * j + 1]; const int s0 = seg + 8 * j;
            u32x4 o; o.x = cvt_pk_bf16(s0 + 0 <= wt ? x0[0] : 0.f, s0 + 1 <= wt ? x0[1] : 0.f); o.y = cvt_pk_bf16(s0 + 2 <= wt ? x0[2] : 0.f, s0 + 3 <= wt ? x0[3] : 0.f);
            o.z = cvt_pk_bf16(s0 + 4 <= wt ? x1[0] : 0.f, s0 + 5 <= wt ? x1[1] : 0.f); o.w = cvt_pk_bf16(s0 + 6 <= wt ? x1[2] : 0.f, s0 + 7 <= wt ? x1[3] : 0.f);
            *(LAS u32x4*)(Wl + wt * 136 + s0) = o; }
        __syncthreads();
        f32x4 acc[8];
#pragma unroll
        for (int cb = 0; cb < 8; ++cb) acc[cb] = (f32x4){0.f, 0.f, 0.f, 0.f};
        const int nsb = (w >> 1) + 1;
        for (int sb = 0; sb < nsb; ++sb) {
            const bf16x8 tf = *(const LAS bf16x8*)(Wl + (16 * w + fr) * 136 + 32 * sb + 8 * fq);
#pragma unroll
            for (int cb = 0; cb < 8; ++cb) { const bf16x8 cf = *(const LAS bf16x8*)(vT + (16 * cb + fr) * 136 + 32 * sb + 8 * fq); acc[cb] = mfma16(cf, tf, acc[cb]); }
        }
#pragma unroll
        for (int cb = 0; cb < 8; ++cb) { const int c = g * 128 + 16 * cb + 4 * fq;
            u32x2 o; o.x = cvt_pk_bf16(bflo(ur[cb].x) * (acc[cb][0] + bsv), bfhi(ur[cb].x) * (acc[cb][1] + bsv)); o.y = cvt_pk_bf16(bflo(ur[cb].y) * (acc[cb][2] + bsv), bfhi(ur[cb].y) * (acc[cb][3] + bsv));
            *(u32x2*)(YG + hrow * 512 + c) = o; }
        __syncthreads();
    }
}
__device__ __forceinline__ void fprep_phase(const Args& a, int l, LAS unsigned char* lds) {
    const int tid = otid(), lane = tid & 63, w = tid >> 6;
    const bf16* H = (const bf16*)(a.ws + WS_H);
    float* GF = (float*)(a.ws + WS_GF);
    LAS float* WT = (LAS float*)lds;
    for (int j = (int)gridDim.x - 1 - obid(); j < 32; j += gridDim.x) {
        const int bl = j >> 3, h = j & 7;
        const float fb = a.fox_fb[l * 8 + h];
        const int p0 = w * 512 + lane * 8;
        const bf16* p = H + (size_t)(bl * SEQ + p0) * HP + C_AF + h;
        float ls[8]; float run = 0.f;
#pragma unroll
        for (int i = 0; i < 8; ++i) { const float z = bf2f(p[(size_t)i * HP]) + fb; ls[i] = fminf(z, 0.f) - log1pf(__expf(-fabsf(z))); run += ls[i]; }
        float incl = run;
#pragma unroll
        for (int o = 1; o < 64; o <<= 1) { const float t = __shfl_up(incl, o); if (lane >= o) incl += t; }
        if (lane == 63) WT[w] = incl;
        __syncthreads();
        float acc = incl - run;
        for (int ww = 0; ww < w; ++ww) acc += WT[ww];
        float* gp = GF + (size_t)(bl * 8 + h) * SEQ + p0;
#pragma unroll
        for (int i = 0; i < 8; ++i) { acc += ls[i]; gp[i] = acc * LOG2E; }
        __syncthreads();
    }
}
__device__ __forceinline__ void norms_phase(const Args& a, LAS unsigned char* lds) {
    const int tid = otid(), lane = tid & 63, w = tid >> 6, row = tid >> 3, ch = tid & 7;
    const bf16* H = (const bf16*)(a.ws + WS_H);
    float* KN = (float*)(a.ws + WS_KN); float* QN = (float*)(a.ws + WS_QN);
    LAS float* km = (LAS float*)lds; LAS float* qm = (LAS float*)(lds + 256);
    for (int u = obid(); u < 256; u += gridDim.x) {
        const int bl = u >> 6, h = (u >> 3) & 7, tg = u & 7;
        u32x4 kx[8], qx[8];
#pragma unroll
        for (int tt = 0; tt < 8; ++tt) { const size_t r = (size_t)(bl * SEQ + (tg * 8 + tt) * 64 + row) * HP + h * 64 + ch * 8; kx[tt] = *(const u32x4*)(H + r + C_AK); qx[tt] = *(const u32x4*)(H + r + C_AQ); }
#pragma unroll
        for (int tt = 0; tt < 8; ++tt) {
            float ks = 0.f, qs = 0.f;
#pragma unroll
            for (int e = 0; e < 4; ++e) { const float k0 = bflo(kx[tt][e]), k1 = bfhi(kx[tt][e]), q0 = bflo(qx[tt][e]), q1 = bfhi(qx[tt][e]); ks += k0 * k0 + k1 * k1; qs += q0 * q0 + q1 * q1; }
            ks += __shfl_xor(ks, 1); ks += __shfl_xor(ks, 2); ks += __shfl_xor(ks, 4); qs += __shfl_xor(qs, 1); qs += __shfl_xor(qs, 2); qs += __shfl_xor(qs, 4);
            ks = fmaxf(ks, __shfl_xor(ks, 8)); ks = fmaxf(ks, __shfl_xor(ks, 16)); ks = fmaxf(ks, __shfl_xor(ks, 32)); qs = fmaxf(qs, __shfl_xor(qs, 8)); qs = fmaxf(qs, __shfl_xor(qs, 16)); qs = fmaxf(qs, __shfl_xor(qs, 32));
            if (lane == 0) { km[tt * 8 + w] = ks; qm[tt * 8 + w] = qs; }
        }
        __syncthreads();
        if (tid < 8) { float m = 0.f; for (int ww = 0; ww < 8; ++ww) m = fmaxf(m, km[tid * 8 + ww]); KN[(bl * 8 + h) * 64 + tg * 8 + tid] = sqrtf(m) * 1.01f; }
        else if (tid < 10) { const int qh = tid - 8; float m = 0.f; for (int i = 0; i < 32; ++i) m = fmaxf(m, qm[qh * 32 + i]); QN[(bl * 8 + h) * 16 + tg * 2 + qh] = sqrtf(m) * 1.01f; }
        __syncthreads();
    }
}
__device__ __forceinline__ void hgrn_gates(const bf16 (&zr)[16], float lb, int col, int part, LAS float* PS, float (&kk)[16], float (&cum)[16], float& last, float& rmid) {
    float run = 0.f; const float lbf = fmaxf(lb, 1e-30f), omlb = 1.f - lb;
#pragma unroll
    for (int i = 0; i < 16; ++i) { const float z = bf2f(zr[i]); const float sg = 1.f / (1.f + __expf(-z)), sgn = 1.f / (1.f + __expf(z));
        const float lf = logf(lbf + omlb * sg); kk[i] = omlb * sgn; run += lf; cum[i] = run; }
    PS[part * 128 + col] = run; __syncthreads();
    const float p0 = PS[col], p1 = PS[128 + col], p2 = PS[256 + col], p3 = PS[384 + col];
    const float prefix = (part > 0 ? p0 : 0.f) + (part > 1 ? p1 : 0.f) + (part > 2 ? p2 : 0.f);
    last = (p0 + p1) + (p2 + p3); rmid = p0 + p1;
#pragma unroll
    for (int i = 0; i < 16; ++i) cum[i] += prefix;
}
__device__ __forceinline__ float hgrn_lb(const Args& a, int l, int j) { if (l == 0) return 0.f; return 1.f / (1.f + __expf(a.lb_logits[j] - a.lb_logits[512 + j])); }
__device__ __forceinline__ void h1_load(const bf16* H, int u, int col, int part, bf16 (&zr)[16], bf16 (&vr)[16]) {
    const int c = u & 63, h = (u >> 6) & 3, bl = u >> 8; const bf16* p = H + (size_t)(bl * SEQ + c * 64 + 16 * part) * HP + h * 128 + col;
#pragma unroll
    for (int i = 0; i < 16; ++i) { zr[i] = p[(size_t)i * HP + C_RF]; vr[i] = p[(size_t)i * HP + C_RI]; }
}
__device__ __forceinline__ void hgrn1_phase(const Args& a, int l, LAS unsigned char* lds) {
    const int tid = otid(), lane = tid & 63, w = tid >> 6, fr = lane & 15, fq = lane >> 4, col = tid & 127, part = tid >> 7;
    const bf16* H = (const bf16*)(a.ws + WS_H);
    bf16* U = (bf16*)(a.ws + WS_U); float* DEC = (float*)(a.ws + WS_DEC);
    LAS bf16* KT = (LAS bf16*)lds;
    LAS bf16* VT = (LAS bf16*)(lds + 18432);
    LAS float* PS = (LAS float*)(lds + 36864);
    const int G = gridDim.x;
    bf16 zr[16], vr[16];
    int u = obid();
    if (u < 1024) h1_load(H, u, col, part, zr, vr);
    for (; u < 1024; u += G) {
        const int c = u & 63, h = (u >> 6) & 3, bl = u >> 8;
        const float lb = hgrn_lb(a, l, h * 128 + col);
        float kk[16], cum[16], last, rmid;
        hgrn_gates(zr, lb, col, part, PS, kk, cum, last, rmid);
#pragma unroll
        for (int i = 0; i < 16; ++i) { const int s = 16 * part + i; KT[col * 72 + s] = f2bf(kk[i] * __expf(last - cum[i])); VT[col * 72 + s] = vr[i]; }
        if (u + G < 1024) h1_load(H, u + G, col, part, zr, vr);
        const size_t ci = (size_t)((bl * 4 + h) * 64 + c);
        if (part == 0) DEC[ci * 128 + col] = __expf(last);
        __syncthreads();
        bf16x8 vf[2];
#pragma unroll
        for (int ks = 0; ks < 2; ++ks) vf[ks] = *(const LAS bf16x8*)(VT + (16 * w + fr) * 72 + 32 * ks + 8 * fq);
#pragma unroll
        for (int kb = 0; kb < 8; ++kb) { f32x4 acc = (f32x4){0.f, 0.f, 0.f, 0.f};
#pragma unroll
            for (int ks = 0; ks < 2; ++ks) { const bf16x8 kf = *(const LAS bf16x8*)(KT + (16 * kb + fr) * 72 + 32 * ks + 8 * fq); acc = mfma16(kf, vf[ks], acc); }
            u32x2 o; o.x = cvt_pk_bf16(acc[0], acc[1]); o.y = cvt_pk_bf16(acc[2], acc[3]);
            *(u32x2*)(U + (ci * 128 + 16 * w + fr) * 128 + 16 * kb + 4 * fq) = o; }
        __syncthreads();
    }
}
__device__ __forceinline__ void hgrn2_phase(const Args& a) {
    unsigned* U = (unsigned*)(a.ws + WS_U); const float* DEC = (const float*)(a.ws + WS_DEC);
    for (int p = obid() * 512 + otid(); p < 131072; p += gridDim.x * 512) {
        const int bh = p >> 13, e2 = p & 8191, k = (e2 * 2) & 127;
        unsigned* up = U + (size_t)bh * 64 * 8192 + e2; const float* dp = DEC + (size_t)bh * 64 * 128 + k;
        float s0 = 0.f, s1 = 0.f;
#pragma unroll 16
        for (int c = 0; c < 64; ++c) { const unsigned uv = up[(size_t)c * 8192]; const float d0 = dp[c * 128], d1 = dp[c * 128 + 1]; up[(size_t)c * 8192] = cvt_pk_bf16(s0, s1); s0 = d0 * s0 + bflo(uv); s1 = d1 * s1 + bfhi(uv); }
    }
}
__device__ __forceinline__ void h3_load(const bf16* H, int u, int col, int part, bf16 (&zr)[16], bf16 (&qr)[16], bf16 (&vr)[16]) {
    const int c = u & 63, h = (u >> 6) & 3, bl = u >> 8; const bf16* p = H + (size_t)(bl * SEQ + c * 64 + 16 * part) * HP + h * 128 + col;
#pragma unroll
    for (int i = 0; i < 16; ++i) { zr[i] = p[(size_t)i * HP + C_RF]; qr[i] = p[(size_t)i * HP + C_RQ]; vr[i] = p[(size_t)i * HP + C_RI]; }
}
__device__ __forceinline__ void hgrn3_phase(const Args& a, int l, LAS unsigned char* lds) {
    const int tid = otid(), lane = tid & 63, w = tid >> 6, fr = lane & 15, fq = lane >> 4, col = tid & 127, part = tid >> 7;
    const bf16* H = (const bf16*)(a.ws + WS_H);
    const bf16* U = (const bf16*)(a.ws + WS_U);
    bf16* YR = (bf16*)(a.ws + WS_Y) + (size_t)TH * 512;
    LAS bf16* QI = (LAS bf16*)lds;
    LAS bf16* QH = (LAS bf16*)(lds + 17408);
    LAS bf16* KH = (LAS bf16*)(lds + 34816);
    LAS bf16* VT = (LAS bf16*)(lds + 52224);
    LAS bf16* SC = (LAS bf16*)(lds + 70656);
    LAS float* PS = (LAS float*)(lds + 79872);
    LAS float* RS = (LAS float*)(lds + 81920);
    const float* nw = a.r_norm_w + l * 128;
    const int G = gridDim.x, tb = w & 3, hw = w >> 2;
    bf16 zr[16], qr[16], vr[16];
    int u = obid();
    if (u < 1024) h3_load(H, u, col, part, zr, qr, vr);
    for (; u < 1024; u += G) {
        const int c = u & 63, h = (u >> 6) & 3, bl = u >> 8; const int s0 = bl * SEQ + c * 64;
        const size_t ci = (size_t)((bl * 4 + h) * 64 + c);
        bf16x8 uf[4][4];
#pragma unroll
        for (int nb = 0; nb < 4; ++nb)
#pragma unroll
            for (int ks = 0; ks < 4; ++ks) uf[nb][ks] = *(const bf16x8*)(U + (ci * 128 + hw * 64 + nb * 16 + fr) * 128 + 32 * ks + 8 * fq);
        const size_t hrow = (size_t)(s0 + 16 * tb + fr);
        u32x2 gr[4];
#pragma unroll
        for (int nb = 0; nb < 4; ++nb) gr[nb] = *(const u32x2*)(H + hrow * HP + C_RG + h * 128 + hw * 64 + nb * 16 + 4 * fq);
        const float lb = hgrn_lb(a, l, h * 128 + col);
        float kk[16], cum[16], last, rmid;
        hgrn_gates(zr, lb, col, part, PS, kk, cum, last, rmid);
#pragma unroll
        for (int i = 0; i < 16; ++i) { const int s = 16 * part + i; const float q = bf2f(qr[i]);
            QI[s * 136 + col] = f2bf(q * __expf(cum[i])); QH[s * 136 + col] = f2bf(q * __expf(cum[i] - rmid)); KH[s * 136 + col] = f2bf(kk[i] * __expf(rmid - cum[i]));
            VT[col * 72 + s] = vr[i]; }
        if (u + G < 1024) h3_load(H, u + G, col, part, zr, qr, vr);
        __syncthreads();
#pragma unroll
        for (int j = 0; j < 2; ++j) { const int sb = 2 * hw + j; f32x4 acc = (f32x4){0.f, 0.f, 0.f, 0.f};
            if (sb <= tb) {
#pragma unroll
                for (int ks = 0; ks < 4; ++ks) { const bf16x8 kf = *(const LAS bf16x8*)(KH + (16 * sb + fr) * 136 + 32 * ks + 8 * fq), qf = *(const LAS bf16x8*)(QH + (16 * tb + fr) * 136 + 32 * ks + 8 * fq); acc = mfma16(kf, qf, acc); }
            }
            const int t = 16 * tb + fr, sbase = 16 * sb + 4 * fq;
            u32x2 o; o.x = cvt_pk_bf16(sbase + 0 <= t ? acc[0] : 0.f, sbase + 1 <= t ? acc[1] : 0.f); o.y = cvt_pk_bf16(sbase + 2 <= t ? acc[2] : 0.f, sbase + 3 <= t ? acc[3] : 0.f);
            *(LAS u32x2*)(SC + t * 72 + sbase) = o; }
        __syncthreads();
        f32x4 o4[4]; float ssq = 0.f;
        { bf16x8 sf[2], qf[4];
#pragma unroll
            for (int ks = 0; ks < 2; ++ks) sf[ks] = *(const LAS bf16x8*)(SC + (16 * tb + fr) * 72 + 32 * ks + 8 * fq);
#pragma unroll
            for (int ks = 0; ks < 4; ++ks) qf[ks] = *(const LAS bf16x8*)(QI + (16 * tb + fr) * 136 + 32 * ks + 8 * fq);
#pragma unroll
            for (int nb = 0; nb < 4; ++nb) { const int vb = hw * 64 + nb * 16; f32x4 acc = (f32x4){0.f, 0.f, 0.f, 0.f};
#pragma unroll
                for (int ks = 0; ks < 2; ++ks) { const bf16x8 vf = *(const LAS bf16x8*)(VT + (vb + fr) * 72 + 32 * ks + 8 * fq); acc = mfma16(vf, sf[ks], acc); }
#pragma unroll
                for (int ks = 0; ks < 4; ++ks) acc = mfma16(uf[nb][ks], qf[ks], acc);
                o4[nb] = acc; ssq += (acc[0] * acc[0] + acc[1] * acc[1]) + (acc[2] * acc[2] + acc[3] * acc[3]); } }
        ssq += __shfl_xor(ssq, 16); ssq += __shfl_xor(ssq, 32);
        if (fq == 0) RS[hw * 64 + 16 * tb + fr] = ssq;
        __syncthreads();
        { const int t = 16 * tb + fr; const float rstd = 1.f / sqrtf((RS[t] + RS[64 + t]) * (1.f / 128.f) + 1e-6f);
#pragma unroll
            for (int nb = 0; nb < 4; ++nb) { const int v = hw * 64 + nb * 16 + 4 * fq; const f32x4 nv = *(const f32x4*)(nw + v);
                const float g0 = bflo(gr[nb].x), g1 = bfhi(gr[nb].x), g2 = bflo(gr[nb].y), g3 = bfhi(gr[nb].y);
                u32x2 o; o.x = cvt_pk_bf16(o4[nb][0] * rstd * nv[0] * g0 * sigm(g0), o4[nb][1] * rstd * nv[1] * g1 * sigm(g1)); o.y = cvt_pk_bf16(o4[nb][2] * rstd * nv[2] * g2 * sigm(g2), o4[nb][3] * rstd * nv[3] * g3 * sigm(g3));
                *(u32x2*)(YR + hrow * 512 + h * 128 + v) = o; } }
        __syncthreads();
    }
}
__device__ __forceinline__ int crow(int r, int hi) { return (r & 3) + 8 * (r >> 2) + 4 * hi; }
__device__ __forceinline__ void attn_unit(const Args& a, int bl, int h, int qb, LAS unsigned char* lds) {
    const int tid = otid(), lane = tid & 63, w = tid >> 6, r32 = lane & 31, hi = lane >> 5;
    const bf16* H = (const bf16*)(a.ws + WS_H);
    const float* G = (const float*)(a.ws + WS_GF) + (size_t)(bl * 8 + h) * SEQ;
    const float* KN = (const float*)(a.ws + WS_KN) + (bl * 8 + h) * 64; const float* QN = (const float*)(a.ws + WS_QN) + (bl * 8 + h) * 16;
    bf16* YA = (bf16*)(a.ws + WS_Y) + (size_t)2 * TH * 512;
    LAS bf16* Ks = (LAS bf16*)lds;
    LAS bf16* VT = (LAS bf16*)(lds + 9216);
    LAS float* Gs = (LAS float*)(lds + 18432);
    LAS int* TL = (LAS int*)(lds + 18688);
    const size_t rowbase = (size_t)bl * SEQ;
    const int q0 = qb * 256 + w * 32;
    const int NT = 4 * qb + 4;
    __syncthreads();
    if (w == 0) { bool act = false;
        if (lane < NT) { const float qmax = QN[qb]; const float kd = fmaxf(fmaxf(KN[4 * qb], KN[4 * qb + 1]), fmaxf(KN[4 * qb + 2], KN[4 * qb + 3]));
            act = (lane >= 4 * qb) || (qmax * KN[lane] + (G[256 * qb] - G[64 * lane + 63]) >= -qmax * kd - 40.f); }
        const unsigned long long mask = __ballot(act);
        if (act) TL[1 + __popcll(mask & ((1ull << lane) - 1ull))] = lane;
        if (lane == 0) TL[0] = __popcll(mask); }
    bf16x8 qr[4];
#pragma unroll
    for (int d0 = 0; d0 < 4; ++d0) qr[d0] = *(const bf16x8*)(H + (rowbase + q0 + r32) * HP + C_AQ + h * 64 + d0 * 16 + hi * 8);
    const float Gq = G[q0 + r32];
    float m = -1e30f, lsum = 0.f; f32x16 oT[2];
#pragma unroll
    for (int r = 0; r < 16; ++r) { oT[0][r] = 0.f; oT[1][r] = 0.f; }
    const int kvr = tid >> 3, ch = tid & 7;
    const int kvp = (kvr & ~12) | ((kvr & 4) << 1) | ((kvr & 8) >> 1);
    const bf16* kp = H + (rowbase + kvr) * HP + C_AK + h * 64 + ch * 8;
    const bf16* vp = H + (rowbase + kvr) * HP + C_AV + h * 64 + ch * 8;
    __syncthreads();
    const int nact = TL[0];
    int t = TL[1];
    u32x4 kreg = *(const u32x4*)(kp + (size_t)t * 64 * HP), vreg = *(const u32x4*)(vp + (size_t)t * 64 * HP); float greg = (tid < 64) ? G[t * 64 + tid] : 0.f;
    for (int it = 0; it < nact; ++it) {
        __syncthreads();
        *(LAS u32x4*)(Ks + kvr * 72 + ch * 8) = kreg;
        { LAS bf16* vd = VT + (ch * 8) * 72 + kvp;
          vd[0 * 72] = (bf16)(vreg.x & 0xffffu); vd[1 * 72] = (bf16)(vreg.x >> 16); vd[2 * 72] = (bf16)(vreg.y & 0xffffu); vd[3 * 72] = (bf16)(vreg.y >> 16);
          vd[4 * 72] = (bf16)(vreg.z & 0xffffu); vd[5 * 72] = (bf16)(vreg.z >> 16); vd[6 * 72] = (bf16)(vreg.w & 0xffffu); vd[7 * 72] = (bf16)(vreg.w >> 16); }
        if (tid < 64) Gs[tid] = greg;
        __syncthreads();
        const int kv0 = 64 * t;
        if (it + 1 < nact) { t = TL[2 + it]; kreg = *(const u32x4*)(kp + (size_t)t * 64 * HP); vreg = *(const u32x4*)(vp + (size_t)t * 64 * HP); if (tid < 64) greg = G[t * 64 + tid]; }
        if (kv0 > q0 + 31) continue;
        f32x16 p0, p1;
#pragma unroll
        for (int r = 0; r < 16; ++r) { p0[r] = 0.f; p1[r] = 0.f; }
#pragma unroll
        for (int d0 = 0; d0 < 4; ++d0) { const bf16x8 k0 = *(const LAS bf16x8*)(Ks + r32 * 72 + d0 * 16 + hi * 8), k1 = *(const LAS bf16x8*)(Ks + (32 + r32) * 72 + d0 * 16 + hi * 8);
            p0 = mfma32(k0, qr[d0], p0); p1 = mfma32(k1, qr[d0], p1); }
#pragma unroll
        for (int rg = 0; rg < 4; ++rg) { const f32x4 g0 = *(const LAS f32x4*)(Gs + 8 * rg + 4 * hi), g1 = *(const LAS f32x4*)(Gs + 32 + 8 * rg + 4 * hi);
#pragma unroll
            for (int e = 0; e < 4; ++e) { p0[4 * rg + e] += Gq - g0[e]; p1[4 * rg + e] += Gq - g1[e]; } }
        if (kv0 + 63 > q0) { const int q = q0 + r32;
#pragma unroll
            for (int r = 0; r < 16; ++r) { const int kv = kv0 + crow(r, hi); if (kv > q) p0[r] = -1e30f; if (kv + 32 > q) p1[r] = -1e30f; } }
        float mx = fmaxf(p0[0], p1[0]);
#pragma unroll
        for (int r = 1; r < 16; ++r) mx = fmaxf(mx, fmaxf(p0[r], p1[r]));
        mx = fmaxf(mx, __shfl_xor(mx, 32));
        const float mnew = fmaxf(m, mx), alpha = __builtin_amdgcn_exp2f(m - mnew); m = mnew;
        float rs = 0.f;
#pragma unroll
        for (int r = 0; r < 16; ++r) { p0[r] = __builtin_amdgcn_exp2f(p0[r] - mnew); p1[r] = __builtin_amdgcn_exp2f(p1[r] - mnew); rs += p0[r] + p1[r]; }
        lsum = lsum * alpha + rs;
#pragma unroll
        for (int r = 0; r < 16; ++r) { oT[0][r] *= alpha; oT[1][r] *= alpha; }
        u32x4 pw[4];
#pragma unroll
        for (int j = 0; j < 2; ++j) { pw[j] = (u32x4){cvt_pk_bf16(p0[8 * j + 0], p0[8 * j + 1]), cvt_pk_bf16(p0[8 * j + 2], p0[8 * j + 3]), cvt_pk_bf16(p0[8 * j + 4], p0[8 * j + 5]), cvt_pk_bf16(p0[8 * j + 6], p0[8 * j + 7])};
            pw[2 + j] = (u32x4){cvt_pk_bf16(p1[8 * j + 0], p1[8 * j + 1]), cvt_pk_bf16(p1[8 * j + 2], p1[8 * j + 3]), cvt_pk_bf16(p1[8 * j + 4], p1[8 * j + 5]), cvt_pk_bf16(p1[8 * j + 6], p1[8 * j + 7])}; }
#pragma unroll
        for (int dh = 0; dh < 2; ++dh)
#pragma unroll
            for (int j = 0; j < 4; ++j) { const bf16x8 vf = *(const LAS bf16x8*)(VT + (dh * 32 + r32) * 72 + 16 * j + 8 * hi); oT[dh] = mfma32(vf, __builtin_bit_cast(bf16x8, pw[j]), oT[dh]); }
    }
    lsum += __shfl_xor(lsum, 32);
    const float inv = 1.f / lsum;
    bf16* op = YA + (rowbase + q0 + r32) * 512 + h * 64;
#pragma unroll
    for (int dh = 0; dh < 2; ++dh)
#pragma unroll
        for (int rg = 0; rg < 4; ++rg) { u32x2 o; o.x = cvt_pk_bf16(oT[dh][4 * rg + 0] * inv, oT[dh][4 * rg + 1] * inv); o.y = cvt_pk_bf16(oT[dh][4 * rg + 2] * inv, oT[dh][4 * rg + 3] * inv);
            *(u32x2*)(op + dh * 32 + 8 * rg + 4 * hi) = o; }
}
__device__ __forceinline__ void attn_phase(const Args& a, LAS unsigned char* lds) {
    const int G = gridDim.x, bx = obid();
    const int vcu0 = (G % 8 == 0) ? (bx % 8) * (G / 8) + bx / 8 : bx;
    for (int v = vcu0; v < 256; v += G) { const int bh = v >> 3, s = v & 7;
        attn_unit(a, bh >> 3, bh & 7, 15 - s, lds); attn_unit(a, bh >> 3, bh & 7, s, lds); }
}
#define XB_TMO      128
#define XB_XCNT(j)  (256  + 64 * (j))
#define XB_XSUB(j)  (1280 + 64 * (j))
#define XB_XGEN(j)  (2304 + 64 * (j))
#define XB_TOP      3328
#define XB_TOPGEN   3392
#define XCD_BAR_WORDS 3456
#define XB_SPIN_CAP (1u << 18)

__device__ __forceinline__ unsigned xb_ld(unsigned* p)              { return __hip_atomic_load(p, __ATOMIC_RELAXED, __HIP_MEMORY_SCOPE_AGENT); }
__device__ __forceinline__ unsigned xb_add(unsigned* p, unsigned v) { return __hip_atomic_fetch_add(p, v, __ATOMIC_RELAXED, __HIP_MEMORY_SCOPE_AGENT); }
__device__ __forceinline__ unsigned xb_xcc_id() { return (unsigned)__builtin_amdgcn_s_getreg((3 << 11) | 20) & 0xFu; }
#define XB_SPIN(cond, bar) do { unsigned _sp = 0; while (cond) { __builtin_amdgcn_s_sleep(1); \
    if ((++_sp & 255u) == 0u) { if (xb_ld(&(bar)[XB_TMO])) break; if (_sp > XB_SPIN_CAP) { atomicAdd(&(bar)[XB_TMO], 1u); break; } } } } while (0)

struct XcdBarrier {
    unsigned* bar; unsigned x;
    volatile LAS unsigned* st;
};

__device__ __forceinline__ XcdBarrier xcd_barrier_post(unsigned* bar, volatile LAS unsigned* st) {
    XcdBarrier b; b.bar = bar; b.x = xb_xcc_id(); b.st = st;
    if (threadIdx.x == 0) (void)xb_add(&bar[XB_XCNT(b.x)], 1u);
    return b;
}
__device__ __forceinline__ void xcd_barrier_complete(unsigned* bar, unsigned x, unsigned& nloc, unsigned& nx) {
    const unsigned G = gridDim.x * gridDim.y * gridDim.z;
    unsigned sum, cnt, mine, sp = 0u;
    for (;;) {
        sum = 0u; cnt = 0u; mine = 0u;
#pragma unroll
        for (unsigned j = 0; j < 16; ++j) { const unsigned c = xb_ld(&bar[XB_XCNT(j)]); sum += c; cnt += (c > 0u) ? 1u : 0u; mine = (j == x) ? c : mine; }
        if (sum == G) break;
        __builtin_amdgcn_s_sleep(1);
        if ((++sp & 255u) == 0u) { if (xb_ld(&bar[XB_TMO])) break; if (sp > XB_SPIN_CAP) { atomicAdd(&bar[XB_TMO], 1u); break; } }
    }
    nloc = mine > 0u ? mine : 1u; nx = cnt > 0u ? cnt : 1u;
}

__device__ __forceinline__ void xcd_barrier(const XcdBarrier& b) {
    asm volatile("s_waitcnt vmcnt(0)" ::: "memory");
    __syncthreads();
    if (threadIdx.x == 0) {
        unsigned* bar = b.bar;
        __builtin_amdgcn_s_waitcnt(0);
        unsigned nloc = b.st[0], nx = b.st[1];
        if (nloc == 0u) { xcd_barrier_complete(bar, b.x, nloc, nx); b.st[0] = nloc; b.st[1] = nx; }
        const unsigned old = xb_add(&bar[XB_XSUB(b.x)], 1u);
        const unsigned gen = old / nloc;
        if (old + 1u == (gen + 1u) * nloc) {
            __builtin_amdgcn_fence(__ATOMIC_RELEASE, "agent");
            asm volatile("s_waitcnt vmcnt(0)" ::: "memory");
            const unsigned og = xb_add(&bar[XB_TOP], 1u);
            const unsigned tg = og / nx;
            if (og + 1u == (tg + 1u) * nx) xb_add(&bar[XB_TOPGEN], 1u);
            else XB_SPIN(xb_ld(&bar[XB_TOPGEN]) == tg, bar);
            __builtin_amdgcn_fence(__ATOMIC_ACQUIRE, "agent");
            xb_add(&bar[XB_XGEN(b.x)], 1u);
            asm volatile("s_waitcnt vmcnt(0)" ::: "memory");
        } else {
            XB_SPIN(xb_ld(&bar[XB_XGEN(b.x)]) == gen, bar);
            __builtin_amdgcn_fence(__ATOMIC_ACQUIRE, "agent");
            asm volatile("s_waitcnt vmcnt(0)" ::: "memory");
        }
    }
    __syncthreads();
}

#ifndef PH_MASK
#define PH_MASK 0xffff
#endif
#define PHON(k) ((PH_MASK >> (k)) & 1)
#ifndef PH_REP
#define PH_REP 0ull
#endif
#ifndef SYNC_EXTRA
#define SYNC_EXTRA 0
#endif
#define REPN(k) (1 + (int)((PH_REP >> (2 * (k))) & 3ull))
__device__ __forceinline__ void run_phase(const Args& a, int p, LAS unsigned char* lds) {
    if (p == 0) { if (PHON(0)) prep_phase(a, lds); return; }
    const int l = (p - 1) >> 4, q = (p - 1) & 15;
    unsigned char* wl = a.ws + WS_W + (size_t)l * W_LAYER;
    bf16* XB = (bf16*)(a.ws + WS_XB); bf16* Hh = (bf16*)(a.ws + WS_H); bf16* Y = (bf16*)(a.ws + WS_Y); bf16* MB = (bf16*)(a.ws + WS_MB);
    const float alpha = 1.4142135623730951f;
    if (q < 12) {
        const int hb = q / 6, s = q % 6;
        if (s == 0) { if (PHON(1)) { pg8::Gemm g{XB + (size_t)hb * TH * DM, (const bf16*)(wl + WIN_OFF), TH, HP, DM}; pg8::StaticOrder S; S.init(TH, HP, gridDim.x, obid());
            pg8::EpiH E{Hh}; pg8::gemm_phase<pg8::EpiH, pg8::StaticOrder, PG8_ALIGN, PG8_SP2>(lds, g, S, E); } }
        else if (s == 1) { for (int r_ = 0; r_ < REPN(2); ++r_) { if (PHON(2)) gmlp_phase(a, l, lds); if (PHON(3)) { fprep_phase(a, l, lds); norms_phase(a, lds); } if (PHON(4)) hgrn1_phase(a, l, lds); } }
        else if (s == 2) { if (PHON(5)) hgrn2_phase(a); for (int r_ = 0; r_ < REPN(6); ++r_) if (PHON(6)) attn_phase(a, lds); }
        else if (s == 3) { for (int r_ = 0; r_ < REPN(7); ++r_) if (PHON(7)) hgrn3_phase(a, l, lds); }
        else if (s == 4) { if (PHON(8)) { pg8::Gemm g{Y, (const bf16*)(wl + WP_OFF), 3 * TH, 3 * DM, 512}; pg8::ProjOrder S{(int)gridDim.x, obid()};
            pg8::EpiProj E{Hh, MB}; pg8::gemm_phase<pg8::EpiProj, pg8::ProjOrder, PG8_ALIGN, PG8_SP2>(lds, g, S, E); } }
        else { if (PHON(9)) { pg8::Gemm g{MB, (const bf16*)(wl + WO_OFF), TH, DM, DM}; pg8::StaticOrder S; S.init(TH, DM, gridDim.x, obid());
            const float* base = (l == 0 ? a.x : a.out) + (size_t)hb * TH * DM;
            pg8::EpiResid E{base, a.out + (size_t)hb * TH * DM, alpha}; pg8::gemm_phase<pg8::EpiResid, pg8::StaticOrder, PG8_ALIGN, PG8_SP2>(lds, g, S, E); } }
        return;
    }
    if (q == 12) { if (PHON(10)) ln_phase(a.out, a.ln1_g + l * DM, a.ln1_b + l * DM, XB); return; }
    if (q == 13) { if (PHON(11)) { pg8::Gemm g{XB, (const bf16*)(wl + WGU_OFF), T_ALL, 2 * DFF, DM}; pg8::StaticOrder S; S.init(T_ALL, 2 * DFF, gridDim.x, obid());
        pg8::EpiSwiglu E{Hh}; pg8::gemm_phase<pg8::EpiSwiglu, pg8::StaticOrder, PG8_ALIGN, PG8_SP2>(lds, g, S, E); } return; }
    if (q == 14) { if (PHON(12)) { pg8::Gemm g{Hh, (const bf16*)(wl + WD_OFF), T_ALL, DM, DFF}; pg8::StaticOrder S; S.init(T_ALL, DM, gridDim.x, obid());
        pg8::EpiResid E{a.out, a.out, alpha}; pg8::gemm_phase<pg8::EpiResid, pg8::StaticOrder, PG8_ALIGN, PG8_SP2>(lds, g, S, E); } return; }
    if (PHON(10)) ln_phase(a.out, a.ln2_g + l * DM, a.ln2_b + l * DM, XB);
}
__global__ void __launch_bounds__(512, 2) mega(Args a) {
    extern __shared__ __attribute__((aligned(16))) unsigned char lds_raw[];
    LAS unsigned char* lds = (LAS unsigned char*)lds_raw;
    cg::grid_group grid = cg::this_grid();
    volatile LAS unsigned* misc = (volatile LAS unsigned*)(lds + 131072 + 256);
    XcdBarrier bar; bar.bar = (unsigned*)(a.ws + WS_CTL); bar.x = 0; bar.st = nullptr;
    if (a.hi - a.lo > 1) {
        if (threadIdx.x < 16) misc[threadIdx.x] = 0u;
        __syncthreads();
        bar = xcd_barrier_post((unsigned*)(a.ws + WS_CTL), misc + 8);
    }
    for (int p = a.lo; p < a.hi; ++p) {
        Args b = a; asm volatile("" : "+s"(b.ws), "+s"(b.out));
        run_phase(b, p, lds);
        if (p + 1 < a.hi) { if (p == a.lo) grid.sync(); else xcd_barrier(bar); for (int e_ = 0; e_ < SYNC_EXTRA; ++e_) xcd_barrier(bar); }
    }
}

#ifndef MK_DEBUG
#define MK_DEBUG 0
#endif
#if MK_DEBUG
__global__ void __launch_bounds__(256) dbg_check(const unsigned* base, size_t nwords, int type, unsigned long long* ctl, int p, int rep, int r) {
    unsigned long long cs = 0ull, nf = 0ull;
    for (size_t i = (size_t)blockIdx.x * 256 + threadIdx.x; i < nwords; i += (size_t)gridDim.x * 256) { const unsigned w = base[i];
        cs += (unsigned long long)w * (2ull * i + 1ull);
        if (type == 1) { if ((w & 0x7f800000u) >= (141u << 23)) ++nf; } else { if ((w & 0x7f80u) >= (141u << 7)) ++nf; if ((w & 0x7f800000u) >= (141u << 23)) ++nf; } }
    for (int o = 1; o < 64; o <<= 1) { cs += __shfl_xor(cs, o); nf += __shfl_xor(nf, o); }
    if ((threadIdx.x & 63) == 0) { atomicAdd(ctl + 64 + (rep * 64 + p) * 4 + r, cs); if (nf) atomicAdd(ctl + p, nf); }
}
__global__ void __launch_bounds__(256) dbg_report(const unsigned long long* ctl, float* out, size_t n) {
    int code = 0;
    if (ctl[40]) code = 90;
    for (int p = 0; p < NPHASE && !code; ++p) { if (ctl[p]) code = 3 + p; else for (int r = 0; r < 4; ++r) if (ctl[64 + p * 4 + r] != ctl[64 + (64 + p) * 4 + r]) code = 40 + p; }
    if (!code) return;
    for (size_t i = (size_t)blockIdx.x * 256 + threadIdx.x; i < n; i += (size_t)gridDim.x * 256) out[i] = (float)code;
}
__global__ void __launch_bounds__(256) dbg_g1(const float* w_in, const unsigned char* ws, unsigned long long* ctl, int hb) {
    const unsigned hsh = (blockIdx.x + 1u) * 2654435761u; const int row = (hsh >> 8) % TH; const int n = 1024 + (int)((hsh * 40503u >> 4) % (INC - 1024));
    const bf16* XB = (const bf16*)(ws + WS_XB) + ((size_t)hb * TH + row) * DM; const bf16* H = (const bf16*)(ws + WS_H);
    float s = 0.f; for (int k = threadIdx.x; k < DM; k += 256) s += bf2f(XB[k]) * w_in[(size_t)k * INC + n];
    __shared__ float red[256]; red[threadIdx.x] = s; __syncthreads();
    if (threadIdx.x == 0) { float t = 0.f; for (int i = 0; i < 256; ++i) t += red[i]; if (n >= 3072 && n < 3584) t *= pg8::QSCALE;
        const float got = bf2f(H[(size_t)row * HP + rowmap(1, n)]); if (!(fabsf(got - t) <= 0.03f + 0.03f * fabsf(t))) atomicAdd(ctl + 40, 1ull); }
}
struct DbgReg { size_t off; size_t bytes; int type; int in_out; };
static int dbg_regions(int p, DbgReg* R) {
    if (p == 0) { R[0] = {WS_W, WS_H - WS_W, 0, 0}; return 1; }
    const int q = (p - 1) & 15;
    if (q < 12) { const int hb = q / 6, s = q % 6;
        if (s == 0) { R[0] = {WS_H, 248 * MiB, 0, 0}; return 1; }
        if (s == 1) { R[0] = {WS_Y, 16 * MiB, 0, 0}; R[1] = {WS_U, 32 * MiB, 0, 0}; R[2] = {WS_DEC, 1 * MiB, 1, 0}; return 3; }
        if (s == 2) { R[0] = {WS_U, 32 * MiB, 0, 0}; R[1] = {WS_Y + 32 * MiB, 16 * MiB, 0, 0}; return 2; }
        if (s == 3) { R[0] = {WS_Y + 16 * MiB, 16 * MiB, 0, 0}; return 1; }
        if (s == 4) { R[0] = {WS_MB, 32 * MiB, 0, 0}; return 1; }
        R[0] = {(size_t)hb * 64 * MiB, 64 * MiB, 1, 1}; return 1; }
    if (q == 13) { R[0] = {WS_H, 176 * MiB, 0, 0}; return 1; }
    if (q == 14) { R[0] = {0, 128 * MiB, 1, 1}; return 1; }
    R[0] = {0, 128 * MiB, 1, 1}; R[1] = {WS_XB, 64 * MiB, 0, 0}; return 2;
}
#endif
#ifndef MK_MULTI
#define MK_MULTI 0
#endif
extern "C" void kernel_launch(void* const* d_in, const int* in_sizes, int n_in, void* d_out, int out_size, void* d_ws, size_t ws_size, hipStream_t stream) {
    static int grid = 0;
    if (grid == 0) {
        if (n_in != 20 || out_size != T_ALL * DM || ws_size < WS_END) { fprintf(stderr, "kernel_launch: unexpected shapes (n_in %d out %d ws %zu)\n", n_in, out_size, ws_size); grid = -1; return; }
        if (hipFuncSetAttribute((const void*)mega, hipFuncAttributeMaxDynamicSharedMemorySize, LDS_BYTES) != hipSuccess) { fprintf(stderr, "kernel_launch: hipFuncSetAttribute failed\n"); grid = -1; return; }
        int dev = 0, cus = 0, per_cu = 0;
        (void)hipGetDevice(&dev); (void)hipDeviceGetAttribute(&cus, hipDeviceAttributeMultiprocessorCount, dev);
        (void)hipOccupancyMaxActiveBlocksPerMultiprocessor(&per_cu, (const void*)mega, 512, LDS_BYTES);
        if (per_cu < 1) per_cu = 1;
        grid = cus;
        (void)hipGetLastError();
    }
    if (grid < 0) return;
    Args a{};
    const float** ap = (const float**)&a;
    for (int i = 0; i < 20; ++i) ap[i] = (const float*)d_in[i];
    a.out = (float*)d_out; a.ws = (unsigned char*)d_ws;
#if MK_DEBUG
    (void)hipMemsetAsync(d_ws, 0xAA, WS_END, stream); (void)hipMemsetAsync(d_out, 0xAA, (size_t)T_ALL * DM * 4, stream); (void)hipMemsetAsync(d_ws, 0, 1 * MiB, stream);
    for (int rep = 0; rep < 2; ++rep)
        for (int p = 0; p < NPHASE; ++p) { a.lo = p; a.hi = p + 1; hipLaunchKernelGGL(mega, dim3(grid), dim3(512), LDS_BYTES, stream, a);
            if (p == 1 && rep == 0) hipLaunchKernelGGL(dbg_g1, dim3(2048), dim3(256), 0, stream, (const float*)d_in[1], (const unsigned char*)d_ws, (unsigned long long*)d_ws, 0);
            DbgReg R[4]; const int nr = dbg_regions(p, R);
            for (int r = 0; r < nr; ++r) hipLaunchKernelGGL(dbg_check, dim3(1024), dim3(256), 0, stream, (const unsigned*)((R[r].in_out ? (unsigned char*)d_out : (unsigned char*)d_ws) + R[r].off), R[r].bytes / 4, R[r].type, (unsigned long long*)d_ws, p, rep, r); }
    hipLaunchKernelGGL(dbg_report, dim3(1024), dim3(256), 0, stream, (const unsigned long long*)d_ws, (float*)d_out, (size_t)T_ALL * DM);
#elif MK_MULTI
    for (int p = 0; p < NPHASE; ++p) { a.lo = p; a.hi = p + 1; hipLaunchKernelGGL(mega, dim3(grid), dim3(512), LDS_BYTES, stream, a); }
#else
    a.lo = 0; a.hi = NPHASE;
    (void)hipMemsetAsync(d_ws, 0, 65536, stream);
    void* args[] = {&a};
    hipError_t e = hipLaunchCooperativeKernel((const void*)mega, dim3(grid), dim3(512), args, LDS_BYTES, stream);
    if (e != hipSuccess) fprintf(stderr, "cooperative launch failed: %s (grid %d)\n", hipGetErrorString(e), grid);
#endif
}
```
